# Optimizing an MI355X kernel written in HIP

```python
import jax, jax.numpy as jnp
from jax import lax
import numpy as np

D_MODEL = 1024
BATCH = 8
SEQ = 2048
DEPTH = 1
DEC_BATCH = 128
DEC_SEQ = 4
PAST_LEN = 16384
PAGE_SIZE = 128

RG_WIDTH = D_MODEL
RG_BLOCKS = 8
RG_BLOCK = RG_WIDTH // RG_BLOCKS
RG_C = 8.0
CONV_W = 4
SSD_EXPAND = 2
SSD_INNER = SSD_EXPAND * D_MODEL
SSD_HEAD_DIM = 64
SSD_HEADS = SSD_INNER // SSD_HEAD_DIM
SSD_GROUPS = 8
SSD_HPG = SSD_HEADS // SSD_GROUPS
SSD_STATE = 128
SSD_CHUNK = 128
SSD_CONV_DIM = SSD_INNER + 2 * SSD_GROUPS * SSD_STATE
D_FF = 2816
EPS = 1e-6
IN_SIZES = (RG_WIDTH, RG_WIDTH, SSD_INNER, SSD_CONV_DIM, SSD_HEADS, D_MODEL, D_MODEL)
D_IN = sum(IN_SIZES)

kernel_name = "hawk_ssd_parallel_macaron_decoder_step"


def rmsnorm(x, w):
    xf = x.astype(jnp.float32)
    y = xf * lax.rsqrt(jnp.mean(xf * xf, axis=-1, keepdims=True) + EPS)
    return (y * w.astype(jnp.float32)).astype(x.dtype)


def swiglu(x, wg, wu, wd):
    return (jax.nn.silu(x @ wg) * (x @ wu)) @ wd


def causal_conv(x, buf, w, b):
    L = x.shape[1]
    xc = jnp.concatenate([buf.astype(x.dtype), x], axis=1)
    y = xc[:, 0:L] * w[0]
    for k in range(1, CONV_W):
        y = y + xc[:, k:k + L] * w[k]
    return y + b, xc[:, -(CONV_W - 1):]


def rg_lru(x, pos, h0, wa, ba, wx, bx, lam):
    b, l, _ = x.shape
    xf = x.astype(jnp.float32)
    xb = xf.reshape(b, l, RG_BLOCKS, RG_BLOCK)
    gate_a = jax.nn.sigmoid(jnp.einsum('blhi,hij->blhj', xb, wa).reshape(b, l, RG_WIDTH) + ba)
    gate_x = jax.nn.sigmoid(jnp.einsum('blhi,hij->blhj', xb, wx).reshape(b, l, RG_WIDTH) + bx)
    log_a = -RG_C * gate_a * jax.nn.softplus(-lam.astype(jnp.float32))
    reset = (pos == 0)[None, :, None]
    a = jnp.where(reset, 0.0, jnp.exp(log_a))
    mult = jnp.where(reset, 1.0, jnp.sqrt(-jnp.expm1(2.0 * log_a)))
    u = xf * gate_x * mult

    def combine(lft, rgt):
        return (lft[0] * rgt[0], rgt[0] * lft[1] + rgt[1])

    a_cum, u_cum = lax.associative_scan(combine, (a, u), axis=1)
    h = a_cum * h0.astype(jnp.float32)[:, None] + u_cum
    return h, h[:, -1]


def ssd_scan(x, dt, A, B, C, h0):
    b, l = x.shape[:2]
    q = min(SSD_CHUNK, l)
    nc = -(-l // q)
    pad = nc * q - l
    if pad:
        pw = lambda t: jnp.pad(t, [(0, 0), (0, pad)] + [(0, 0)] * (t.ndim - 2))
        x, dt, B, C = pw(x), pw(dt), pw(B), pw(C)
    G, R, P, N = SSD_GROUPS, SSD_HPG, SSD_HEAD_DIM, SSD_STATE
    x = x.reshape(b, nc, q, G, R, P)
    dt = dt.reshape(b, nc, q, G, R)
    B = B.reshape(b, nc, q, G, N)
    C = C.reshape(b, nc, q, G, N)
    acs = jnp.cumsum(dt * A.reshape(G, R), axis=2)
    seg = acs[:, :, :, None] - acs[:, :, None, :]
    mask = jnp.tril(jnp.ones((q, q), bool))[:, :, None, None]
    lmat = jnp.exp(jnp.where(mask, seg, -jnp.inf))
    cb = jnp.einsum('bcign,bcjgn->bcijg', C, B)
    w = cb[..., None] * lmat * dt[:, :, None]
    y_diag = jnp.einsum('bcijgr,bcjgrp->bcigrp', w, x)
    decay = jnp.exp(acs[:, :, -1:] - acs)
    chunk_states = jnp.einsum('bcjgn,bcjgr,bcjgrp->bcgrpn', B, decay * dt, x)
    chunk_decay = jnp.exp(acs[:, :, -1])

    def step(s, inp):
        cs, cd = inp
        return cd[..., None, None] * s + cs, s

    final, s_in = lax.scan(step, h0.astype(jnp.float32).reshape(b, G, R, P, N),
                           (jnp.moveaxis(chunk_states, 1, 0), jnp.moveaxis(chunk_decay, 1, 0)))
    s_in = jnp.moveaxis(s_in, 0, 1)
    y_off = jnp.einsum('bcign,bcgrpn->bcigrp', C, s_in) * jnp.exp(acs)[..., None]
    y = (y_diag + y_off).reshape(b, nc * q, SSD_HEADS, P)[:, :l]
    return y, final.reshape(b, SSD_HEADS, P, N)


def mixer(u, pos, rg_h0, rg_buf, ssd_h0, ssd_buf, p):
    b, l, _ = u.shape
    f32 = jnp.float32
    proj = u @ p['w_in']
    cuts = [int(c) for c in np.cumsum(IN_SIZES)[:-1]]
    rg_x, rg_g, z, xbc, dt_raw, g_rg, g_ssd = jnp.split(proj, cuts, axis=-1)
    rg_xc, rg_buf_new = causal_conv(rg_x, rg_buf, p['rg_conv_w'], p['rg_conv_b'])
    h, rg_h_new = rg_lru(rg_xc, pos, rg_h0, p['rg_wa'], p['rg_ba'], p['rg_wx'], p['rg_bx'], p['rg_lambda'])
    y_rg = h * jax.nn.gelu(rg_g.astype(f32))
    xbc_c, ssd_buf_new = causal_conv(xbc, ssd_buf, p['ssd_conv_w'], p['ssd_conv_b'])
    xbc_c = jax.nn.silu(xbc_c.astype(f32))
    xs, Bs, Cs = jnp.split(xbc_c, [SSD_INNER, SSD_INNER + SSD_GROUPS * SSD_STATE], axis=-1)
    dt = jax.nn.softplus(dt_raw.astype(f32) + p['ssd_dt_bias'])
    A = -jnp.exp(p['ssd_a_log'].astype(f32))
    xh = xs.reshape(b, l, SSD_HEADS, SSD_HEAD_DIM)
    y, ssd_h_new = ssd_scan(xh, dt, A, Bs.reshape(b, l, SSD_GROUPS, SSD_STATE),
                            Cs.reshape(b, l, SSD_GROUPS, SSD_STATE), ssd_h0)
    y = (y + p['ssd_d'][:, None] * xh).reshape(b, l, SSD_INNER) * jax.nn.silu(z.astype(f32))
    yg = y.reshape(b, l, SSD_GROUPS, SSD_INNER // SSD_GROUPS)
    yg = yg * lax.rsqrt(jnp.mean(yg * yg, axis=-1, keepdims=True) + EPS)
    y_ssd = yg.reshape(b, l, SSD_INNER) * p['ssd_norm_w']
    m = (jax.nn.sigmoid(g_rg.astype(f32)) * (y_rg @ p['w_proj_rg'])
         + jax.nn.sigmoid(g_ssd.astype(f32)) * (y_ssd @ p['w_proj_ssd']))
    out = (m @ p['w_out']).astype(u.dtype)
    new = (rg_h_new.astype(rg_h0.dtype), rg_buf_new.astype(rg_buf.dtype),
           ssd_h_new.astype(ssd_h0.dtype), ssd_buf_new.astype(ssd_buf.dtype))
    return out, new


def layer(x, pos, rg_h0, rg_buf, ssd_h0, ssd_buf, p):
    x = x + 0.5 * rmsnorm(swiglu(rmsnorm(x, p['n_ffn1_pre']), p['ffn1_wg'], p['ffn1_wu'], p['ffn1_wd']),
                          p['n_ffn1_post'])
    mix, new = mixer(rmsnorm(x, p['n_mix_pre']), pos, rg_h0, rg_buf, ssd_h0, ssd_buf, p)
    x = x + rmsnorm(mix, p['n_mix_post'])
    x = x + 0.5 * rmsnorm(swiglu(rmsnorm(x, p['n_ffn2_pre']), p['ffn2_wg'], p['ffn2_wu'], p['ffn2_wd']),
                          p['n_ffn2_post'])
    return x, new


def setup_inputs(seed: int = 0) -> dict:
    key = jax.random.key(seed)
    ks = iter(jax.random.split(key, 48))
    f32 = jnp.float32
    nrm = lambda shape, s: jax.random.normal(next(ks), shape, f32) * s
    gain = lambda n: 1.0 + nrm((DEPTH, n), 0.05)
    d = {}
    d['x_prompt'] = nrm((BATCH, SEQ, D_MODEL), 1.0)
    d['x_sample'] = nrm((DEC_BATCH, DEC_SEQ, D_MODEL), 1.0)
    d['state_rg_h'] = nrm((DEPTH, DEC_BATCH, RG_WIDTH), 0.5)
    d['state_rg_conv'] = nrm((DEPTH, DEC_BATCH, CONV_W - 1, RG_WIDTH), 1.0)
    d['state_ssd'] = nrm((DEPTH, DEC_BATCH, SSD_HEADS, SSD_HEAD_DIM, SSD_STATE), 0.3)
    d['state_ssd_conv'] = nrm((DEPTH, DEC_BATCH, CONV_W - 1, SSD_CONV_DIM), 1.0)
    d['n_ffn1_pre'] = gain(D_MODEL)
    d['n_ffn1_post'] = gain(D_MODEL)
    d['ffn1_wg'] = nrm((DEPTH, D_MODEL, D_FF), D_MODEL ** -0.5)
    d['ffn1_wu'] = nrm((DEPTH, D_MODEL, D_FF), D_MODEL ** -0.5)
    d['ffn1_wd'] = nrm((DEPTH, D_FF, D_MODEL), D_FF ** -0.5)
    d['n_mix_pre'] = gain(D_MODEL)
    d['n_mix_post'] = gain(D_MODEL)
    d['w_in'] = nrm((DEPTH, D_MODEL, D_IN), D_MODEL ** -0.5)
    d['rg_conv_w'] = nrm((DEPTH, CONV_W, RG_WIDTH), CONV_W ** -0.5)
    d['rg_conv_b'] = nrm((DEPTH, RG_WIDTH), 0.02)
    d['rg_wa'] = nrm((DEPTH, RG_BLOCKS, RG_BLOCK, RG_BLOCK), RG_BLOCK ** -0.5)
    d['rg_ba'] = nrm((DEPTH, RG_WIDTH), 0.1)
    d['rg_wx'] = nrm((DEPTH, RG_BLOCKS, RG_BLOCK, RG_BLOCK), RG_BLOCK ** -0.5)
    d['rg_bx'] = nrm((DEPTH, RG_WIDTH), 0.1)
    a_c = jax.random.uniform(next(ks), (DEPTH, RG_WIDTH), f32, 0.9, 0.999)
    s = a_c ** (1.0 / RG_C)
    d['rg_lambda'] = jnp.log(s) - jnp.log1p(-s)
    d['ssd_conv_w'] = nrm((DEPTH, CONV_W, SSD_CONV_DIM), CONV_W ** -0.5)
    d['ssd_conv_b'] = nrm((DEPTH, SSD_CONV_DIM), 0.02)
    dt0 = jnp.exp(jax.random.uniform(next(ks), (DEPTH, SSD_HEADS), f32, np.log(1e-3), np.log(1e-1)))
    d['ssd_dt_bias'] = dt0 + jnp.log(-jnp.expm1(-dt0))
    d['ssd_a_log'] = jnp.log(jax.random.uniform(next(ks), (DEPTH, SSD_HEADS), f32, 1.0, 16.0))
    d['ssd_d'] = 1.0 + nrm((DEPTH, SSD_HEADS), 0.1)
    d['ssd_norm_w'] = gain(SSD_INNER)
    d['w_proj_rg'] = nrm((DEPTH, RG_WIDTH, D_MODEL), RG_WIDTH ** -0.5)
    d['w_proj_ssd'] = nrm((DEPTH, SSD_INNER, D_MODEL), SSD_INNER ** -0.5)
    d['w_out'] = nrm((DEPTH, D_MODEL, D_MODEL), D_MODEL ** -0.5)
    d['n_ffn2_pre'] = gain(D_MODEL)
    d['n_ffn2_post'] = gain(D_MODEL)
    d['ffn2_wg'] = nrm((DEPTH, D_MODEL, D_FF), D_MODEL ** -0.5)
    d['ffn2_wu'] = nrm((DEPTH, D_MODEL, D_FF), D_MODEL ** -0.5)
    d['ffn2_wd'] = nrm((DEPTH, D_FF, D_MODEL), D_FF ** -0.5)
    return d


def reference(x_prompt, x_sample, state_rg_h, state_rg_conv, state_ssd, state_ssd_conv,
              n_ffn1_pre, n_ffn1_post, ffn1_wg, ffn1_wu, ffn1_wd, n_mix_pre, n_mix_post, w_in,
              rg_conv_w, rg_conv_b, rg_wa, rg_ba, rg_wx, rg_bx, rg_lambda,
              ssd_conv_w, ssd_conv_b, ssd_dt_bias, ssd_a_log, ssd_d, ssd_norm_w,
              w_proj_rg, w_proj_ssd, w_out, n_ffn2_pre, n_ffn2_post, ffn2_wg, ffn2_wu, ffn2_wd):
    params = dict(n_ffn1_pre=n_ffn1_pre, n_ffn1_post=n_ffn1_post, ffn1_wg=ffn1_wg, ffn1_wu=ffn1_wu,
                  ffn1_wd=ffn1_wd, n_mix_pre=n_mix_pre, n_mix_post=n_mix_post, w_in=w_in,
                  rg_conv_w=rg_conv_w, rg_conv_b=rg_conv_b, rg_wa=rg_wa, rg_ba=rg_ba, rg_wx=rg_wx,
                  rg_bx=rg_bx, rg_lambda=rg_lambda, ssd_conv_w=ssd_conv_w, ssd_conv_b=ssd_conv_b,
                  ssd_dt_bias=ssd_dt_bias, ssd_a_log=ssd_a_log, ssd_d=ssd_d, ssd_norm_w=ssd_norm_w,
                  w_proj_rg=w_proj_rg, w_proj_ssd=w_proj_ssd, w_out=w_out, n_ffn2_pre=n_ffn2_pre,
                  n_ffn2_post=n_ffn2_post, ffn2_wg=ffn2_wg, ffn2_wu=ffn2_wu, ffn2_wd=ffn2_wd)
    bp, lp = x_prompt.shape[:2]
    ls = x_sample.shape[1]
    pos_p = jnp.arange(lp, dtype=jnp.int32)
    pos_s = PAST_LEN + jnp.arange(ls, dtype=jnp.int32)
    yp, ys = x_prompt, x_sample
    p_new = ([], [], [], [])
    s_new = ([], [], [], [])
    for li in range(DEPTH):
        p = {k: v[li] for k, v in params.items()}
        z_rg_h = jnp.zeros((bp,) + state_rg_h.shape[2:], state_rg_h.dtype)
        z_rg_c = jnp.zeros((bp,) + state_rg_conv.shape[2:], state_rg_conv.dtype)
        z_ssd = jnp.zeros((bp,) + state_ssd.shape[2:], state_ssd.dtype)
        z_ssd_c = jnp.zeros((bp,) + state_ssd_conv.shape[2:], state_ssd_conv.dtype)
        yp, newp = layer(yp, pos_p, z_rg_h, z_rg_c, z_ssd, z_ssd_c, p)
        ys, news = layer(ys, pos_s, state_rg_h[li], state_rg_conv[li], state_ssd[li], state_ssd_conv[li], p)
        for lst, v in zip(p_new, newp):
            lst.append(v)
        for lst, v in zip(s_new, news):
            lst.append(v)
    prompt_rg_h, prompt_rg_conv, prompt_ssd, prompt_ssd_conv = [jnp.stack(v, 0) for v in p_new]
    sample_rg_h, sample_rg_conv, sample_ssd, sample_ssd_conv = [jnp.stack(v, 0) for v in s_new]
    return (yp, ys, prompt_rg_h, prompt_rg_conv, prompt_ssd, prompt_ssd_conv,
            sample_rg_h, sample_rg_conv, sample_ssd, sample_ssd_conv)
```

```cpp
#include <hip/hip_runtime.h>
#include <hip/hip_cooperative_groups.h>
#include <cstdio>
namespace cg = cooperative_groups;

#ifndef MULTI_LAUNCH
#define MULTI_LAUNCH 0
#endif

#define LAS __attribute__((address_space(3)))
typedef unsigned short bf16_t;
typedef short bf16x8 __attribute__((ext_vector_type(8)));
typedef float f32x4 __attribute__((ext_vector_type(4)));
typedef unsigned u32x4 __attribute__((ext_vector_type(4)));
typedef unsigned u32x2 __attribute__((ext_vector_type(2)));

constexpr int MTOT = 16896, MP = 16384, MS = 512, DM = 1024, DFF = 2816, NUP = 5632, LDP = 10240, NIN = 10496;
constexpr int NPH = 14;
constexpr int LDS_BYTES = 149504;

constexpr size_t WS_UP1 = 0;
constexpr size_t WS_DN1 = WS_UP1 + (size_t)NUP * DM * 2;
constexpr size_t WS_UP2 = WS_DN1 + (size_t)DM * DFF * 2;
constexpr size_t WS_DN2 = WS_UP2 + (size_t)NUP * DM * 2;
constexpr size_t WS_IN = WS_DN2 + (size_t)DM * DFF * 2;
constexpr size_t WS_PRG = WS_IN + (size_t)NIN * DM * 2;
constexpr size_t WS_PSSD = WS_PRG + (size_t)DM * DM * 2;
constexpr size_t WS_OUT = WS_PSSD + (size_t)DM * 2048 * 2;
constexpr size_t WS_GA = WS_OUT + (size_t)DM * DM * 2;
constexpr size_t WS_GX = WS_GA + (size_t)8 * 128 * 128 * 2;
constexpr size_t WS_XN = WS_GX + (size_t)8 * 128 * 128 * 2;
constexpr size_t WS_D = WS_XN + (size_t)MTOT * DM * 2;
constexpr size_t WS_PROJ = WS_D + (size_t)MTOT * DM * 4;
constexpr size_t WS_DT = WS_PROJ + (size_t)MTOT * LDP * 2;
constexpr size_t WS_RGTOT = WS_DT + (size_t)MTOT * 32 * 4;
constexpr size_t WS_END = WS_RGTOT + (size_t)128 * 1024 * 8;
constexpr size_t BC_BATCH = (size_t)2048 * 2048 * 2;
constexpr size_t WS_BAR = WS_END + 2 * BC_BATCH;
constexpr size_t WS_SLOTS = WS_BAR + 16384;
constexpr size_t WS_SSLOTS = WS_SLOTS + (size_t)2 * MP * 4 * 8;
constexpr size_t WS_NEED = WS_SSLOTS + (size_t)2 * MS * 16 * 8;
constexpr size_t WS_XN2 = WS_PROJ + (size_t)200 * 1024 * 1024;
__device__ __forceinline__ bf16_t* bc_base(unsigned char* ws, int b) {
    return (bf16_t*)(ws + (b < 4 ? WS_XN + (size_t)b * BC_BATCH : (b < 6 ? WS_UP1 + (size_t)(b - 4) * BC_BATCH : WS_END + (size_t)(b - 6) * BC_BATCH)));
}

constexpr size_t O_Y = 0;
constexpr size_t O_PRGH = (size_t)MTOT * DM;
constexpr size_t O_PRGC = O_PRGH + 8 * 1024;
constexpr size_t O_PSSD = O_PRGC + 8 * 3 * 1024;
constexpr size_t O_PSSDC = O_PSSD + (size_t)8 * 32 * 64 * 128;
constexpr size_t O_SRGH = O_PSSDC + 8 * 3 * 4096;
constexpr size_t O_SRGC = O_SRGH + 128 * 1024;
constexpr size_t O_SSSD = O_SRGC + 128 * 3 * 1024;
constexpr size_t O_SSSDC = O_SSSD + (size_t)128 * 32 * 64 * 128;

struct Params {
    const float* in[35];
    float* out;
    unsigned char* ws;
    int ph_lo, ph_hi;
};

__device__ __forceinline__ unsigned pk_bf16(float lo, float hi) { unsigned r; asm volatile("v_cvt_pk_bf16_f32 %0, %1, %2" : "=v"(r) : "v"(lo), "v"(hi)); return r; }
__device__ __forceinline__ bf16_t f2bf(float f) { return (bf16_t)(pk_bf16(f, 0.f) & 0xffffu); }
__device__ __forceinline__ float bf2f(bf16_t h) { return __uint_as_float((unsigned)h << 16); }
__device__ __forceinline__ float bflo(unsigned u) { return __uint_as_float(u << 16); }
__device__ __forceinline__ float bfhi(unsigned u) { return __uint_as_float(u & 0xffff0000u); }
__device__ __forceinline__ float sigmoidf_(float x) { return __builtin_amdgcn_rcpf(1.f + __expf(-x)); }
__device__ __forceinline__ float siluf_(float x) { return x * sigmoidf_(x); }
__device__ __forceinline__ float geluf_(float v) { return v * sigmoidf_(1.5957691216057308f * (v + 0.044715f * v * v * v)); }
__device__ __forceinline__ float log1p_pos(float e) { return e < 0.06f ? e * (1.f + e * (-0.5f + e * (0.33333333f + e * -0.25f))) : __logf(1.f + e); }
__device__ __forceinline__ float softplusf_(float x) { return x > 20.f ? x : log1p_pos(__expf(x)); }
__device__ __forceinline__ float neg_expm1_neg(float x) {
    return x > -0.25f ? -x * (1.f + x * (0.5f + x * (0.16666667f + x * (0.041666668f + x * 0.0083333338f)))) : 1.f - __expf(x);
}
__device__ __forceinline__ void lds_barrier() { asm volatile("s_waitcnt lgkmcnt(0)" ::: "memory"); __builtin_amdgcn_s_barrier(); asm volatile("" ::: "memory"); }
__device__ __forceinline__ int bid_l() { int t = blockIdx.x; asm volatile("" : "+s"(t)); return t; }
__device__ __forceinline__ int gdim_l() { int t = gridDim.x; asm volatile("" : "+s"(t)); return t; }
__device__ __forceinline__ int tid_l() { int t = threadIdx.x; asm volatile("" : "+v"(t)); return t; }
__device__ __forceinline__ float bperm(float v, int srclane) { return __int_as_float(__builtin_amdgcn_ds_bpermute(srclane << 2, __float_as_int(v))); }
__device__ __forceinline__ float wave_sum(float v, int lane) {
#pragma unroll
    for (int o = 32; o; o >>= 1) v += bperm(v, lane ^ o);
    return v;
}
__device__ __forceinline__ void unpack8(u32x4 v, float* f) {
    f[0] = bflo(v[0]); f[1] = bfhi(v[0]); f[2] = bflo(v[1]); f[3] = bfhi(v[1]);
    f[4] = bflo(v[2]); f[5] = bfhi(v[2]); f[6] = bflo(v[3]); f[7] = bfhi(v[3]);
}
__device__ __forceinline__ u32x4 pack8(const float* f) {
    u32x4 o; o[0] = pk_bf16(f[0], f[1]); o[1] = pk_bf16(f[2], f[3]); o[2] = pk_bf16(f[4], f[5]); o[3] = pk_bf16(f[6], f[7]); return o;
}

namespace pg8 {
constexpr int BM = 256, BK = 64, HALF = 128, HTB = HALF * BK * 2, STAGE_BYTES = 8 * HTB, NXCD = 8, WGM = 8;
__device__ __forceinline__ int lds_byte(int r, int c) { const int st = (r >> 4) * 2 + (c >> 5), rr = r & 15, cc = c & 31, ob = rr * 64 + cc * 2; return st * 1024 + (ob ^ (((ob >> 9) & 1) << 5)); }
__device__ __forceinline__ void stage_rc(int b, int& R, int& C) { const int st = b / 1024, sb = b % 1024, swz = sb ^ (((sb >> 9) & 1) << 5); R = (st >> 1) * 16 + swz / 64; C = (st & 1) * 32 + (swz % 64) / 2; }
__device__ __forceinline__ int perm32(int rho) { const int n = rho >> 4, i = rho & 15; return 8 * (i >> 2) + 4 * n + (i & 3); }
struct Unit { int pm, pn; };
struct Gemm { const bf16_t* A; const bf16_t* Bt; int M, N, K, lda; };
struct StaticOrder {
    int nM, nN, nwg, G, c;
    __device__ void init(int M, int N, int G_, int c_) { nM = M / BM; nN = N / BM; nwg = nM * nN; G = G_; c = c_; }
    __device__ bool next(int i, Unit& u) const {
        const long L = (long)i * G + c; if (L >= nwg) return false;
        int wgid = (int)L; { const int q = nwg / NXCD, r = nwg % NXCD, xcd = wgid % NXCD, off = wgid / NXCD; wgid = (xcd < r ? xcd * (q + 1) : r * (q + 1) + (xcd - r) * q) + off; }
        const int nig = WGM * nN, gid = wgid / nig, fm = gid * WGM, gsz = (nM - fm) < WGM ? (nM - fm) : WGM;
        u.pm = fm + ((wgid % nig) % gsz); u.pn = (wgid % nig) / gsz; return true;
    }
};

template <class E> constexpr int mid_tile = 0;
template <class Epi>
__device__ __forceinline__ void gemm_phase(LAS unsigned char* lds, const Gemm g, const StaticOrder& S, const Epi& E) {
    const int tid = tid_l(), wid = __builtin_amdgcn_readfirstlane(tid >> 6), lane = tid & 63, wr = wid >> 2, wc = wid & 3, fr = lane & 15, fq = lane >> 4;
    const int K = g.K, nt = K / BK, lda = g.lda;
    unsigned voffA[2], voffB[2];
#pragma unroll
    for (int i = 0; i < 2; ++i) { int R, C; stage_rc(tid * 16 + i * 8192, R, C); const int Rb = (R & ~31) + perm32(R & 31);
        voffA[i] = (unsigned)(R * lda + C) * 2u; voffB[i] = (unsigned)(Rb * K + C) * 2u; }
    const size_t kstep = (size_t)(BK * 2);
    const size_t hstepA = (size_t)HALF * lda * 2, hstepB = (size_t)HALF * K * 2;
    const size_t tstepA = 2 * hstepA, tstepB = 2 * hstepB;
    const unsigned ldsw = (unsigned)wid * 1024u;
    const int aoff = lds_byte(wr * 64 + fr, fq * 8), boff = lds_byte(wc * 32 + fr, fq * 8);
#define PG8_SA(b, h) (((b) * 2 + (h)) * HTB)
#define PG8_SB(b, h) ((4 + (b) * 2 + (h)) * HTB)
#define PG8_STAGE(bufoff, gbase, voff) do { _Pragma("unroll") for (int _i = 0; _i < 2; ++_i) \
        __builtin_amdgcn_global_load_lds((const unsigned*)((const char*)(gbase) + (voff)[_i]), (LAS unsigned*)(lds + (bufoff) + ldsw + _i * 8192), 16, 0, 0); } while (0)
#define PG8_LDA(dst, b, h) do { _Pragma("unroll") for (int m = 0; m < 4; ++m) _Pragma("unroll") for (int k = 0; k < 2; ++k) dst[m][k] = *(const LAS bf16x8*)(lds + PG8_SA(b, h) + aoff + m * 2048 + k * 1024); } while (0)
#define PG8_LDB(dst, b, h) do { _Pragma("unroll") for (int n = 0; n < 2; ++n) _Pragma("unroll") for (int k = 0; k < 2; ++k) dst[n][k] = *(const LAS bf16x8*)(lds + PG8_SB(b, h) + boff + n * 2048 + k * 1024); } while (0)
#define PG8_MMA(ai, bj, At, Bt) do { __builtin_amdgcn_s_setprio(1); _Pragma("unroll") for (int m = 0; m < 4; ++m) _Pragma("unroll") for (int n = 0; n < 2; ++n) _Pragma("unroll") for (int k = 0; k < 2; ++k) \
        acc[ai][bj][m][n] = __builtin_amdgcn_mfma_f32_16x16x32_bf16(Bt[n][k], At[m][k], acc[ai][bj][m][n], 0, 0, 0); __builtin_amdgcn_s_setprio(0); } while (0)
#define PG8_WAIT_V(n) asm volatile("s_waitcnt vmcnt(" #n ")" ::: "memory")
#define PG8_WAIT_L(n) asm volatile("s_waitcnt lgkmcnt(" #n ")" ::: "memory")
#define PG8_BAR __builtin_amdgcn_s_barrier()
#define PG8_SCHED __builtin_amdgcn_sched_barrier(0)
    Unit cur, nxt; int ui = 0;
    if (!S.next(0, cur)) return;
    f32x4 acc[2][2][4][2];
#pragma unroll
    for (int a = 0; a < 2; ++a)
#pragma unroll
        for (int b = 0; b < 2; ++b)
#pragma unroll
            for (int m = 0; m < 4; ++m)
#pragma unroll
                for (int n = 0; n < 2; ++n) acc[a][b][m][n] = (f32x4){0.f, 0.f, 0.f, 0.f};
    bf16x8 At[4][2], B0[2][2], B1[2][2];
    const char* cA = (const char*)g.A + (size_t)cur.pm * tstepA; const char* cB = (const char*)g.Bt + (size_t)cur.pn * tstepB;
    PG8_STAGE(PG8_SB(0, 0), cB, voffB); PG8_STAGE(PG8_SA(0, 0), cA, voffA); PG8_STAGE(PG8_SB(0, 1), cB + hstepB, voffB); PG8_STAGE(PG8_SA(0, 1), cA + hstepA, voffA);
    if (wr == 1) PG8_BAR;
    PG8_WAIT_V(4); PG8_BAR;
    PG8_STAGE(PG8_SB(1, 0), cB + kstep, voffB); PG8_STAGE(PG8_SA(1, 0), cA + kstep, voffA); PG8_STAGE(PG8_SB(1, 1), cB + hstepB + kstep, voffB);
    PG8_WAIT_V(6); PG8_BAR;
    for (;;) {
        const bool has_next = S.next(ui + 1, nxt);
        const char* nA = has_next ? (const char*)g.A + (size_t)nxt.pm * tstepA : cA; const char* nB = has_next ? (const char*)g.Bt + (size_t)nxt.pn * tstepB : cB;
        for (int t = 0; t < nt; t += 2) {
            if constexpr (mid_tile<Epi> != 0) { if (t == mid_tile<Epi>) E.mid(acc, cur, wr, wc, fr, fq); }
            const bool last = (t == nt - 2);
            const char* a1 = cA + (size_t)(t + 1) * kstep;
            const char* a2 = last ? nA : cA + (size_t)(t + 2) * kstep; const char* b2 = last ? nB : cB + (size_t)(t + 2) * kstep;
            const char* a3 = a2 + kstep; const char* b3 = b2 + kstep;
            PG8_LDB(B0, 0, 0); PG8_SCHED; PG8_LDA(At, 0, 0); PG8_STAGE(PG8_SA(1, 1), a1 + hstepA, voffA);
            PG8_WAIT_L(8); PG8_BAR; PG8_WAIT_L(0); PG8_MMA(0, 0, At, B0); PG8_BAR; PG8_SCHED;
            PG8_LDB(B1, 0, 1); PG8_STAGE(PG8_SB(0, 0), b2, voffB);
            PG8_BAR; PG8_WAIT_L(0); PG8_MMA(0, 1, At, B1); PG8_BAR;
            PG8_LDA(At, 0, 1); PG8_STAGE(PG8_SA(0, 0), a2, voffA);
            PG8_BAR; PG8_WAIT_L(0); PG8_MMA(1, 0, At, B0); PG8_BAR; PG8_SCHED;
            PG8_STAGE(PG8_SB(0, 1), b2 + hstepB, voffB);
            PG8_WAIT_V(6); PG8_BAR; PG8_MMA(1, 1, At, B1); PG8_BAR;
            PG8_LDB(B0, 1, 0); PG8_SCHED; PG8_LDA(At, 1, 0); PG8_STAGE(PG8_SA(0, 1), a2 + hstepA, voffA);
            PG8_WAIT_L(8); PG8_BAR; PG8_WAIT_L(0); PG8_MMA(0, 0, At, B0); PG8_BAR; PG8_SCHED;
            PG8_LDB(B1, 1, 1); PG8_STAGE(PG8_SB(1, 0), b3, voffB);
            PG8_BAR; PG8_WAIT_L(0); PG8_MMA(0, 1, At, B1); PG8_BAR;
            PG8_LDA(At, 1, 1); PG8_STAGE(PG8_SA(1, 0), a3, voffA);
            PG8_BAR; PG8_WAIT_L(0); PG8_MMA(1, 0, At, B0); PG8_BAR; PG8_SCHED;
            PG8_STAGE(PG8_SB(1, 1), b3 + hstepB, voffB);
            PG8_WAIT_V(6); PG8_BAR; PG8_MMA(1, 1, At, B1); PG8_BAR;
        }
        if constexpr (!Epi::FUSED) E(acc, cur, wr, wc, fr, fq);
        if (!has_next) break;
#pragma unroll
        for (int a = 0; a < 2; ++a)
#pragma unroll
            for (int b = 0; b < 2; ++b)
#pragma unroll
                for (int m = 0; m < 4; ++m)
#pragma unroll
                    for (int n = 0; n < 2; ++n) acc[a][b][m][n] = (f32x4){0.f, 0.f, 0.f, 0.f};
        cur = nxt; cA = nA; cB = nB; ++ui;
    }
    PG8_WAIT_V(0);
    if (wr == 0) PG8_BAR;
    PG8_BAR;
    if constexpr (Epi::FUSED) E.fused(acc, cur, wr, wc, fr, fq, lds, tid, lane);
#undef PG8_SA
#undef PG8_SB
#undef PG8_STAGE
#undef PG8_LDA
#undef PG8_LDB
#undef PG8_MMA
#undef PG8_WAIT_V
#undef PG8_WAIT_L
#undef PG8_BAR
#undef PG8_SCHED
}
}

struct EpiUp {
    static constexpr bool FUSED = false;
    bf16_t* act;
    __device__ __forceinline__ void operator()(const f32x4 (&acc)[2][2][4][2], const pg8::Unit& u, int wr, int wc, int fr, int fq) const {
        const int row0 = u.pm * 256 + wr * 64 + fr, col0 = u.pn * 128 + wc * 32 + 8 * fq;
#pragma unroll
        for (int ai = 0; ai < 2; ++ai)
#pragma unroll
            for (int m = 0; m < 4; ++m) {
                const f32x4 g0 = acc[ai][0][m][0], g1 = acc[ai][0][m][1], u0 = acc[ai][1][m][0], u1 = acc[ai][1][m][1];
                u32x4 o;
                o[0] = pk_bf16(siluf_(g0[0]) * u0[0], siluf_(g0[1]) * u0[1]); o[1] = pk_bf16(siluf_(g0[2]) * u0[2], siluf_(g0[3]) * u0[3]);
                o[2] = pk_bf16(siluf_(g1[0]) * u1[0], siluf_(g1[1]) * u1[1]); o[3] = pk_bf16(siluf_(g1[2]) * u1[2], siluf_(g1[3]) * u1[3]);
                *(u32x4*)(act + (size_t)(row0 + ai * 128 + m * 16) * DFF + col0) = o;
            }
    }
};
struct EpiF32 {
    static constexpr bool FUSED = false;
    bf16_t* C;
    __device__ __forceinline__ void operator()(const f32x4 (&acc)[2][2][4][2], const pg8::Unit& u, int wr, int wc, int fr, int fq) const {
        const int row0 = u.pm * 256 + wr * 64 + fr, col0 = u.pn * 256 + wc * 32 + 8 * fq;
#pragma unroll
        for (int ai = 0; ai < 2; ++ai)
#pragma unroll
            for (int m = 0; m < 4; ++m) {
                bf16_t* rowp = C + (size_t)(row0 + ai * 128 + m * 16) * DM + col0;
#pragma unroll
                for (int bj = 0; bj < 2; ++bj) {
                    const f32x4 v0 = acc[ai][bj][m][0], v1 = acc[ai][bj][m][1];
                    u32x4 o; o[0] = pk_bf16(v0[0], v0[1]); o[1] = pk_bf16(v0[2], v0[3]); o[2] = pk_bf16(v1[0], v1[1]); o[3] = pk_bf16(v1[2], v1[3]);
                    *(u32x4*)(rowp + bj * 128) = o;
                }
            }
    }
};
struct EpiIn {
    static constexpr bool FUSED = false;
    bf16_t* proj; float* dt; const float* dt_bias;
    __device__ __forceinline__ void operator()(const f32x4 (&acc)[2][2][4][2], const pg8::Unit& u, int wr, int wc, int fr, int fq) const {
        const int row0 = u.pm * 256 + wr * 64 + fr;
        if (u.pn < 40) {
            const int col0 = u.pn * 256 + wc * 32 + 8 * fq;
#pragma unroll
            for (int ai = 0; ai < 2; ++ai)
#pragma unroll
                for (int m = 0; m < 4; ++m) {
                    bf16_t* rowp = proj + (size_t)(row0 + ai * 128 + m * 16) * LDP + col0;
#pragma unroll
                    for (int bj = 0; bj < 2; ++bj) {
                        const f32x4 v0 = acc[ai][bj][m][0], v1 = acc[ai][bj][m][1];
                        u32x4 o; o[0] = pk_bf16(v0[0], v0[1]); o[1] = pk_bf16(v0[2], v0[3]); o[2] = pk_bf16(v1[0], v1[1]); o[3] = pk_bf16(v1[2], v1[3]);
                        __builtin_nontemporal_store(o, (u32x4*)(rowp + bj * 128));
                    }
                }
        } else if (wc == 0) {
            const int lc = 8 * fq;
            const f32x4 b0 = *(const f32x4*)(dt_bias + lc), b1 = *(const f32x4*)(dt_bias + lc + 4);
#pragma unroll
            for (int ai = 0; ai < 2; ++ai)
#pragma unroll
                for (int m = 0; m < 4; ++m) {
                    float* rowp = dt + (size_t)(row0 + ai * 128 + m * 16) * 32 + lc;
                    const f32x4 v0 = acc[ai][0][m][0] + b0, v1 = acc[ai][0][m][1] + b1;
                    f32x4 o0, o1;
#pragma unroll
                    for (int j = 0; j < 4; ++j) { o0[j] = softplusf_(v0[j]); o1[j] = softplusf_(v1[j]); }
                    *(f32x4*)rowp = o0; *(f32x4*)(rowp + 4) = o1;
                }
        }
    }
};
struct EpiGate1 {
    static constexpr bool FUSED = false;
    const bf16_t* gate; bf16_t* t;
    __device__ __forceinline__ void operator()(const f32x4 (&acc)[2][2][4][2], const pg8::Unit& u, int wr, int wc, int fr, int fq) const {
        const int row0 = u.pm * 256 + wr * 64 + fr, col0 = u.pn * 256 + wc * 32 + 8 * fq;
#pragma unroll
        for (int ai = 0; ai < 2; ++ai)
#pragma unroll
            for (int m = 0; m < 4; ++m) {
                const size_t r = (size_t)(row0 + ai * 128 + m * 16);
#pragma unroll
                for (int bj = 0; bj < 2; ++bj) {
                    float gf[8]; unpack8(*(const u32x4*)(gate + r * LDP + col0 + bj * 128), gf);
                    const f32x4 v0 = acc[ai][bj][m][0], v1 = acc[ai][bj][m][1];
                    float o[8];
#pragma unroll
                    for (int j = 0; j < 4; ++j) { o[j] = sigmoidf_(gf[j]) * v0[j]; o[4 + j] = sigmoidf_(gf[4 + j]) * v1[j]; }
                    *(u32x4*)(t + r * DM + col0 + bj * 128) = pack8(o);
                }
            }
    }
};
struct EpiGate2 {
    static constexpr bool FUSED = false;
    const bf16_t* gate; const bf16_t* t; bf16_t* mo;
    __device__ __forceinline__ void operator()(const f32x4 (&acc)[2][2][4][2], const pg8::Unit& u, int wr, int wc, int fr, int fq) const {
        const int row0 = u.pm * 256 + wr * 64 + fr, col0 = u.pn * 256 + wc * 32 + 8 * fq;
#pragma unroll
        for (int ai = 0; ai < 2; ++ai)
#pragma unroll
            for (int m = 0; m < 4; ++m) {
                const size_t r = (size_t)(row0 + ai * 128 + m * 16);
#pragma unroll
                for (int bj = 0; bj < 2; ++bj) {
                    float gf[8]; unpack8(*(const u32x4*)(gate + r * LDP + col0 + bj * 128), gf);
                    float tf[8]; unpack8(*(const u32x4*)(t + r * DM + col0 + bj * 128), tf);
                    const f32x4 v0 = acc[ai][bj][m][0], v1 = acc[ai][bj][m][1];
                    float o[8];
#pragma unroll
                    for (int j = 0; j < 4; ++j) { o[j] = tf[j] + sigmoidf_(gf[j]) * v0[j]; o[4 + j] = tf[4 + j] + sigmoidf_(gf[4 + j]) * v1[j]; }
                    *(u32x4*)(mo + r * DM + col0 + bj * 128) = pack8(o);
                }
            }
    }
};


struct EpiGateCat {
    static constexpr bool FUSED = false;
    const bf16_t* grg; const bf16_t* gssd; bf16_t* mo;
    __device__ __forceinline__ void mid(f32x4 (&acc)[2][2][4][2], const pg8::Unit& u, int wr, int wc, int fr, int fq) const {
        const int rbase = (u.pm * 256 + wr * 64 + fr) * LDP + u.pn * 256 + wc * 32 + 8 * fq;
#pragma unroll
        for (int ai = 0; ai < 2; ++ai)
#pragma unroll
            for (int m = 0; m < 4; ++m) {
                int off = rbase + (ai * 128 + m * 16) * LDP; asm volatile("" : "+v"(off));
#pragma unroll
                for (int bj = 0; bj < 2; ++bj) {
                    float ga[8], gb[8];
                    unpack8(*(const u32x4*)(grg + off + bj * 128), ga);
                    unpack8(*(const u32x4*)(gssd + off + bj * 128), gb);
#pragma unroll
                    for (int j = 0; j < 4; ++j) {
                        acc[ai][bj][m][0][j] *= sigmoidf_(ga[j]) * (1.f + __expf(-gb[j]));
                        acc[ai][bj][m][1][j] *= sigmoidf_(ga[4 + j]) * (1.f + __expf(-gb[4 + j]));
                    }
                }
                __builtin_amdgcn_sched_barrier(0);
            }
        asm volatile("s_waitcnt vmcnt(0)" ::: "memory");
    }
    __device__ __forceinline__ void operator()(const f32x4 (&acc)[2][2][4][2], const pg8::Unit& u, int wr, int wc, int fr, int fq) const {
        const int row0 = u.pm * 256 + wr * 64 + fr, col0 = u.pn * 256 + wc * 32 + 8 * fq;
#pragma unroll
        for (int ai = 0; ai < 2; ++ai)
#pragma unroll
            for (int m = 0; m < 4; ++m) {
                const size_t r = (size_t)(row0 + ai * 128 + m * 16);
#pragma unroll
                for (int bj = 0; bj < 2; ++bj) {
                    float gb[8]; unpack8(*(const u32x4*)(gssd + r * LDP + col0 + bj * 128), gb);
                    const f32x4 v0 = acc[ai][bj][m][0], v1 = acc[ai][bj][m][1];
                    float o[8];
#pragma unroll
                    for (int j = 0; j < 4; ++j) { o[j] = sigmoidf_(gb[j]) * v0[j]; o[4 + j] = sigmoidf_(gb[4 + j]) * v1[j]; }
                    *(u32x4*)(mo + r * DM + col0 + bj * 128) = pack8(o);
                }
            }
    }
};
template <> constexpr int pg8::mid_tile<EpiGateCat> = 16;

struct EpiNorm {
    static constexpr bool FUSED = true;
    const float* res; float* y; bf16_t* xn; const float* wpost; const float* wnext; float scale;
    unsigned long long* slots; unsigned tag;
    __device__ __forceinline__ void row_exchange(const float (&s)[2][4], float (&tot)[2][4], int ex, const pg8::Unit& u, int wr, int wc, int fr, int fq, LAS unsigned char* lds, int tid, int lane) const {
        LAS float* part = (LAS float*)lds; LAS float* rowsum = part + 1024;
        __syncthreads();
#pragma unroll
        for (int ai = 0; ai < 2; ++ai)
#pragma unroll
            for (int m = 0; m < 4; ++m) {
                float v = s[ai][m];
                v += bperm(v, lane ^ 16); v += bperm(v, lane ^ 32);
                if (fq == 0) part[(ai * 128 + wr * 64 + m * 16 + fr) * 4 + wc] = v;
            }
        __syncthreads();
        if (tid < 256) {
            const float mine = part[tid * 4] + part[tid * 4 + 1] + part[tid * 4 + 2] + part[tid * 4 + 3];
            unsigned long long* sl = slots + ((size_t)ex * MP + (size_t)u.pm * 256 + tid) * 4;
            __hip_atomic_store(sl + u.pn, ((unsigned long long)tag << 32) | (unsigned long long)__float_as_uint(mine), __ATOMIC_RELAXED, __HIP_MEMORY_SCOPE_AGENT);
            float total = mine;
            for (int q = 0; q < 4; ++q) {
                if (q == u.pn) continue;
                unsigned long long g;
                while ((unsigned)((g = __hip_atomic_load(sl + q, __ATOMIC_RELAXED, __HIP_MEMORY_SCOPE_AGENT)) >> 32) != tag) __builtin_amdgcn_s_sleep(2);
                total += __uint_as_float((unsigned)g);
            }
            rowsum[tid] = total;
        }
        __syncthreads();
#pragma unroll
        for (int ai = 0; ai < 2; ++ai)
#pragma unroll
            for (int m = 0; m < 4; ++m) tot[ai][m] = rowsum[ai * 128 + wr * 64 + m * 16 + fr];
    }
    __device__ __forceinline__ void fused(f32x4 (&acc)[2][2][4][2], const pg8::Unit& u, int wr, int wc, int fr, int fq, LAS unsigned char* lds, int tid, int lane) const {
        const int row0 = u.pm * 256 + wr * 64 + fr, col0 = u.pn * 256 + wc * 32 + 8 * fq;
        float s[2][4], tot[2][4];
#pragma unroll
        for (int ai = 0; ai < 2; ++ai)
#pragma unroll
            for (int m = 0; m < 4; ++m) {
                float v = 0.f;
#pragma unroll
                for (int bj = 0; bj < 2; ++bj)
#pragma unroll
                    for (int n = 0; n < 2; ++n)
#pragma unroll
                        for (int j = 0; j < 4; ++j) v += acc[ai][bj][m][n][j] * acc[ai][bj][m][n][j];
                s[ai][m] = v;
            }
        row_exchange(s, tot, 0, u, wr, wc, fr, fq, lds, tid, lane);
        f32x4 wp[2][2];
#pragma unroll
        for (int bj = 0; bj < 2; ++bj) { wp[bj][0] = *(const f32x4*)(wpost + col0 + bj * 128); wp[bj][1] = *(const f32x4*)(wpost + col0 + bj * 128 + 4); }
#pragma unroll
        for (int ai = 0; ai < 2; ++ai)
#pragma unroll
            for (int m = 0; m < 4; ++m) {
                const float r = rsqrtf(tot[ai][m] * (1.f / DM) + 1e-6f) * scale;
                const size_t ro = (size_t)(row0 + ai * 128 + m * 16) * DM + col0;
                float v2 = 0.f;
#pragma unroll
                for (int bj = 0; bj < 2; ++bj)
#pragma unroll
                    for (int n = 0; n < 2; ++n) {
                        const f32x4 xr = *(const f32x4*)(res + ro + bj * 128 + n * 4);
                        f32x4 o = xr + acc[ai][bj][m][n] * r * wp[bj][n];
                        acc[ai][bj][m][n] = o;
                        __builtin_nontemporal_store(o, (f32x4*)(y + ro + bj * 128 + n * 4));
                        v2 += o[0] * o[0] + o[1] * o[1] + o[2] * o[2] + o[3] * o[3];
                    }
                s[ai][m] = v2;
            }
        if (wnext) {
            row_exchange(s, tot, 1, u, wr, wc, fr, fq, lds, tid, lane);
#pragma unroll
            for (int bj = 0; bj < 2; ++bj) { wp[bj][0] = *(const f32x4*)(wnext + col0 + bj * 128); wp[bj][1] = *(const f32x4*)(wnext + col0 + bj * 128 + 4); }
#pragma unroll
            for (int ai = 0; ai < 2; ++ai)
#pragma unroll
                for (int m = 0; m < 4; ++m) {
                    const float r2 = rsqrtf(tot[ai][m] * (1.f / DM) + 1e-6f);
                    const size_t ro = (size_t)(row0 + ai * 128 + m * 16) * DM + col0;
#pragma unroll
                    for (int bj = 0; bj < 2; ++bj) {
                        const f32x4 a0 = acc[ai][bj][m][0] * r2 * wp[bj][0], a1 = acc[ai][bj][m][1] * r2 * wp[bj][1];
                        u32x4 o; o[0] = pk_bf16(a0[0], a0[1]); o[1] = pk_bf16(a0[2], a0[3]); o[2] = pk_bf16(a1[0], a1[1]); o[3] = pk_bf16(a1[2], a1[3]);
                        *(u32x4*)(xn + ro + bj * 128) = o;
                    }
                }
        }
    }
};

struct SEpiF32 { static constexpr bool NORM = false; bf16_t* C; __device__ __forceinline__ void operator()(int row, int col, f32x4 s) const { u32x2 o; o[0] = pk_bf16(s[0], s[1]); o[1] = pk_bf16(s[2], s[3]); *(u32x2*)(C + (size_t)row * DM + col) = o; } };
struct SEpiGate1 { static constexpr bool NORM = false; const bf16_t* gate; bf16_t* t;
    __device__ __forceinline__ void operator()(int row, int col, f32x4 s) const {
        const u32x2 gv = *(const u32x2*)(gate + (size_t)row * LDP + col);
        u32x2 o; o[0] = pk_bf16(sigmoidf_(bflo(gv[0])) * s[0], sigmoidf_(bfhi(gv[0])) * s[1]); o[1] = pk_bf16(sigmoidf_(bflo(gv[1])) * s[2], sigmoidf_(bfhi(gv[1])) * s[3]);
        *(u32x2*)(t + (size_t)row * DM + col) = o; } };
struct SEpiGate2 { static constexpr bool NORM = false; const bf16_t* gate; const bf16_t* t; bf16_t* mo;
    __device__ __forceinline__ void operator()(int row, int col, f32x4 s) const {
        const u32x2 gv = *(const u32x2*)(gate + (size_t)row * LDP + col);
        const u32x2 tr = *(const u32x2*)(t + (size_t)row * DM + col);
        const f32x4 tv = {bflo(tr[0]), bfhi(tr[0]), bflo(tr[1]), bfhi(tr[1])};
        u32x2 o; o[0] = pk_bf16(tv[0] + sigmoidf_(bflo(gv[0])) * s[0], tv[1] + sigmoidf_(bfhi(gv[0])) * s[1]);
        o[1] = pk_bf16(tv[2] + sigmoidf_(bflo(gv[1])) * s[2], tv[3] + sigmoidf_(bfhi(gv[1])) * s[3]);
        *(u32x2*)(mo + (size_t)row * DM + col) = o; } };
struct SEpiNorm {
    static constexpr bool NORM = true;
    const float* res; float* y; bf16_t* xn; const float* wpost; const float* wnext; float scale;
    unsigned long long* slots; unsigned tag;
    __device__ __forceinline__ float row_total(float v, int ex, int row, int tc, int lane) const {
        v += bperm(v, lane ^ 1); v += bperm(v, lane ^ 2); v += bperm(v, lane ^ 4); v += bperm(v, lane ^ 8);
        unsigned long long* sl = slots + ((size_t)ex * MS + (size_t)(row - MP)) * 16;
        const int q = lane & 15;
        if (q == 0) __hip_atomic_store(sl + tc, ((unsigned long long)tag << 32) | (unsigned long long)__float_as_uint(v), __ATOMIC_RELAXED, __HIP_MEMORY_SCOPE_AGENT);
        float part = v;
        if (q != tc) {
            unsigned long long g;
            while ((unsigned)((g = __hip_atomic_load(sl + q, __ATOMIC_RELAXED, __HIP_MEMORY_SCOPE_AGENT)) >> 32) != tag) __builtin_amdgcn_s_sleep(2);
            part = __uint_as_float((unsigned)g);
        }
        part += bperm(part, lane ^ 1); part += bperm(part, lane ^ 2); part += bperm(part, lane ^ 4); part += bperm(part, lane ^ 8);
        return part;
    }
    __device__ __forceinline__ void operator()(int row, int col, f32x4 s, int tc, int lane) const {
        const float tot = row_total(s[0] * s[0] + s[1] * s[1] + s[2] * s[2] + s[3] * s[3], 0, row, tc, lane);
        const float r = rsqrtf(tot * (1.f / DM) + 1e-6f) * scale;
        const f32x4 xr = *(const f32x4*)(res + (size_t)row * DM + col), wp = *(const f32x4*)(wpost + col);
        const f32x4 o = xr + s * r * wp;
        *(f32x4*)(y + (size_t)row * DM + col) = o;
        if (wnext) {
            const float tot2 = row_total(o[0] * o[0] + o[1] * o[1] + o[2] * o[2] + o[3] * o[3], 1, row, tc, lane);
            const float r2 = rsqrtf(tot2 * (1.f / DM) + 1e-6f);
            const f32x4 wn = *(const f32x4*)(wnext + col);
            u32x2 ob; ob[0] = pk_bf16(o[0] * r2 * wn[0], o[1] * r2 * wn[1]); ob[1] = pk_bf16(o[2] * r2 * wn[2], o[3] * r2 * wn[3]);
            *(u32x2*)(xn + (size_t)row * DM + col) = ob;
        }
    }
};
template <class Epi>
__device__ __forceinline__ void sgemm_s(LAS unsigned char* lds, const bf16_t* A, int lda, const bf16_t* Bt, int K, const Epi& E, int ldb = 0) {
    const int tid = tid_l(), lane = tid & 63, w = __builtin_amdgcn_readfirstlane(tid >> 6), fr = lane & 15, fq = lane >> 4;
    const int G = gdim_l(), bid = bid_l();
    LAS float* red = (LAS float*)lds;
    const int kw = K >> 3, nks = kw >> 5;
    for (int tile = bid; tile < 256; tile += G) {
        const int row0 = MP + (tile >> 4) * 32, col0 = (tile & 15) * 64;
        f32x4 acc[2][4];
#pragma unroll
        for (int mt = 0; mt < 2; ++mt)
#pragma unroll
            for (int nt = 0; nt < 4; ++nt) acc[mt][nt] = (f32x4){0.f, 0.f, 0.f, 0.f};
        const bf16_t* ap = A + (size_t)(row0 + fr) * lda + w * kw + fq * 8;
        const int ldbe = ldb ? ldb : K;
        const bf16_t* bp = Bt + (size_t)(col0 + fr) * ldbe + w * kw + fq * 8;
        for (int ks0 = 0; ks0 < nks; ks0 += 4) {
            bf16x8 a0[4], a1[4], bb[4][4];
#pragma unroll
            for (int u = 0; u < 4; ++u) {
                const int ks = ks0 + u < nks ? ks0 + u : nks - 1;
                a0[u] = *(const bf16x8*)(ap + ks * 32); a1[u] = *(const bf16x8*)(ap + (size_t)16 * lda + ks * 32);
#pragma unroll
                for (int nt = 0; nt < 4; ++nt) bb[u][nt] = *(const bf16x8*)(bp + (size_t)nt * 16 * ldbe + ks * 32);
            }
            __builtin_amdgcn_s_setprio(1);
#pragma unroll
            for (int u = 0; u < 4; ++u) {
                if (ks0 + u < nks) {
#pragma unroll
                    for (int nt = 0; nt < 4; ++nt) {
                        acc[0][nt] = __builtin_amdgcn_mfma_f32_16x16x32_bf16(a0[u], bb[u][nt], acc[0][nt], 0, 0, 0);
                        acc[1][nt] = __builtin_amdgcn_mfma_f32_16x16x32_bf16(a1[u], bb[u][nt], acc[1][nt], 0, 0, 0);
                    }
                }
            }
            __builtin_amdgcn_s_setprio(0);
        }
        __syncthreads();
#pragma unroll
        for (int mt = 0; mt < 2; ++mt)
#pragma unroll
            for (int nt = 0; nt < 4; ++nt)
#pragma unroll
                for (int r = 0; r < 4; ++r) red[w * 2048 + (mt * 16 + fq * 4 + r) * 64 + nt * 16 + fr] = acc[mt][nt][r];
        __syncthreads();
        f32x4 s = (f32x4){0.f, 0.f, 0.f, 0.f};
#pragma unroll
        for (int ww = 0; ww < 8; ++ww) s += *(const LAS f32x4*)(red + ww * 2048 + (tid >> 4) * 64 + (tid & 15) * 4);
        if constexpr (Epi::NORM) E(row0 + (tid >> 4), col0 + (tid & 15) * 4, s, tile & 15, lane); else E(row0 + (tid >> 4), col0 + (tid & 15) * 4, s);
    }
    __syncthreads();
}

template <int KT>
__device__ __forceinline__ void tr_job(LAS float* tl, const float* src, int ld, int col0, int ncols, int K, bf16_t* dst, int drow0, int dstep, int& base, int G, int wid, int dld = 0) {
    constexpr int NL = KT / 64;
    const int nct = ncols / 32, nkt = K / KT, ntiles = nct * nkt;
    const int first = ((wid - base) % G + G) % G;
    const int tidx = tid_l();
    f32x4 cur[NL], nxt[NL];
    if (first < ntiles) {
        const int ct = first % nct, kt = first / nct;
#pragma unroll
        for (int i = 0; i < NL; ++i) { const int idx = tidx + i * 512, kk = idx >> 3, c4 = idx & 7; cur[i] = __builtin_nontemporal_load((const f32x4*)(src + (size_t)(kt * KT + kk) * ld + col0 + ct * 32 + c4 * 4)); }
    }
    for (int tile = first; tile < ntiles; tile += G) {
        const int ct = tile % nct, kt = tile / nct;
        const int n0 = ct * 32, k0 = kt * KT;
        {
            const int tn = tile + G < ntiles ? tile + G : tile;
            const int ct2 = tn % nct, kt2 = tn / nct;
#pragma unroll
            for (int i = 0; i < NL; ++i) { const int idx = tidx + i * 512, kk = idx >> 3, c4 = idx & 7; nxt[i] = __builtin_nontemporal_load((const f32x4*)(src + (size_t)(kt2 * KT + kk) * ld + col0 + ct2 * 32 + c4 * 4)); }
        }
#pragma unroll
        for (int i = 0; i < NL; ++i) {
            const int idx = tidx + i * 512, kk = idx >> 3, c4 = idx & 7;
            LAS float* q = tl + (c4 * 4) * (KT + 4) + kk; q[0] = cur[i][0]; q[KT + 4] = cur[i][1]; q[2 * (KT + 4)] = cur[i][2]; q[3 * (KT + 4)] = cur[i][3];
        }
        __syncthreads();
#pragma unroll
        for (int j = 0; j < KT / 128; ++j) {
            const int o = tidx + j * 512, n = o / (KT / 8), kq = o % (KT / 8);
            const f32x4 fa = *(const LAS f32x4*)(tl + n * (KT + 4) + kq * 8), fb = *(const LAS f32x4*)(tl + n * (KT + 4) + kq * 8 + 4);
            const float f[8] = {fa[0], fa[1], fa[2], fa[3], fb[0], fb[1], fb[2], fb[3]};
            const int drow = dstep ? drow0 + (n0 + n) * dstep : drow0 + ((n0 + n) >> 7) * 256 + ((n0 + n) & 127);
            *(u32x4*)(dst + (size_t)drow * (dld ? dld : K) + k0 + kq * 8) = pack8(f);
        }
        __syncthreads();
#pragma unroll
        for (int i = 0; i < NL; ++i) cur[i] = nxt[i];
    }
    base = (base + ntiles) % G;
}

__device__ __forceinline__ void prep_dn1(const Params& p, LAS unsigned char* lds, int nw, int wid) {
    int base = 0;
    tr_job<256>((LAS float*)lds, p.in[10], DM, 0, DM, DFF, (bf16_t*)(p.ws + WS_DN1), 0, 1, base, nw, wid);
    tr_job<256>((LAS float*)lds, p.in[32], DFF, 0, DFF, DM, (bf16_t*)(p.ws + WS_UP2), 0, 0, base, nw, wid);
}
__device__ __forceinline__ void prep_late(const Params& p, LAS unsigned char* lds, int nw, int wid) {
    LAS float* tl = (LAS float*)lds; unsigned char* ws = p.ws;
    int base = 0;
    tr_job<256>(tl, p.in[27], DM, 0, DM, DM, (bf16_t*)(ws + WS_PRG), 0, 1, base, nw, wid, 3072);
    tr_job<256>(tl, p.in[28], DM, 0, DM, 2048, (bf16_t*)(ws + WS_PRG) + 1024, 0, 1, base, nw, wid, 3072);
    tr_job<256>(tl, p.in[29], DM, 0, DM, DM, (bf16_t*)(ws + WS_OUT), 0, 1, base, nw, wid);
    tr_job<256>(tl, p.in[33], DFF, 0, DFF, DM, (bf16_t*)(ws + WS_UP2), 128, 0, base, nw, wid);
    tr_job<256>(tl, p.in[34], DM, 0, DM, DFF, (bf16_t*)(ws + WS_DN2), 0, 1, base, nw, wid);
}
__device__ __forceinline__ void phase_prep(const Params& p, LAS unsigned char* lds) {
    LAS float* tl = (LAS float*)lds;
    int base = 0;
    unsigned char* ws = p.ws;
    const int G = gdim_l(), bid = bid_l();
    tr_job<256>(tl, p.in[8], DFF, 0, DFF, DM, (bf16_t*)(ws + WS_UP1), 0, 0, base, G, bid);
    tr_job<256>(tl, p.in[9], DFF, 0, DFF, DM, (bf16_t*)(ws + WS_UP1), 128, 0, base, G, bid);
    tr_job<256>(tl, p.in[13], 10272, 0, 8192, DM, (bf16_t*)(ws + WS_IN), 0, 1, base, G, bid);
    tr_job<256>(tl, p.in[13], 10272, 8224, 2048, DM, (bf16_t*)(ws + WS_IN), 8192, 1, base, G, bid);
    tr_job<256>(tl, p.in[13], 10272, 8192, 32, DM, (bf16_t*)(ws + WS_IN), 10240, 1, base, G, bid);
    for (int hb = 0; hb < 8; ++hb) {
        tr_job<128>(tl, p.in[16] + hb * 16384, 128, 0, 128, 128, (bf16_t*)(ws + WS_GA) + hb * 16384, 0, 1, base, G, bid);
        tr_job<128>(tl, p.in[18] + hb * 16384, 128, 0, 128, 128, (bf16_t*)(ws + WS_GX) + hb * 16384, 0, 1, base, G, bid);
    }
    if (G != 256) { prep_dn1(p, lds, G, bid); prep_late(p, lds, G, bid); }
    {
        u32x4* z = (u32x4*)((bf16_t*)(ws + WS_IN) + (size_t)10272 * DM);
        const int n16 = 224 * DM * 2 / 16;
        unsigned z0 = 0u; asm volatile("" : "+v"(z0));
        const u32x4 zz = {z0, z0, z0, z0};
        for (int i = bid_l() * 512 + tid_l(); i < n16; i += gdim_l() * 512) z[i] = zz;
    }
    {
        u32x4* z = (u32x4*)(ws + WS_SLOTS);
        const int n16 = (int)(((size_t)2 * MP * 4 * 8 + (size_t)2 * MS * 16 * 8) / 16);
        unsigned z0 = 0u; asm volatile("" : "+v"(z0));
        const u32x4 zz = {z0, z0, z0, z0};
        for (int i = bid_l() * 512 + tid_l(); i < n16; i += gdim_l() * 512) z[i] = zz;
    }
    {
        const int tq = tid_l(), lane = tq & 63, wv = __builtin_amdgcn_readfirstlane(tq >> 6);
        const float* w = p.in[6];
        bf16_t* xn = (bf16_t*)(ws + WS_XN);
        const int rstep = gdim_l() * 8;
        for (int rowa = bid_l() * 8 + wv; rowa < MTOT; rowa += 2 * rstep) {
            float4 v[2][4]; float ss[2] = {0.f, 0.f};
#pragma unroll
            for (int q = 0; q < 2; ++q) {
                const int row = rowa + q * rstep < MTOT ? rowa + q * rstep : rowa;
                const float* xr = row < MP ? p.in[0] + (size_t)row * DM : p.in[1] + (size_t)(row - MP) * DM;
#pragma unroll
                for (int i = 0; i < 4; ++i) v[q][i] = *(const float4*)(xr + i * 256 + lane * 4);
            }
#pragma unroll
            for (int q = 0; q < 2; ++q)
#pragma unroll
                for (int i = 0; i < 4; ++i) ss[q] += v[q][i].x * v[q][i].x + v[q][i].y * v[q][i].y + v[q][i].z * v[q][i].z + v[q][i].w * v[q][i].w;
#pragma unroll
            for (int o = 32; o; o >>= 1) { ss[0] += bperm(ss[0], lane ^ o); ss[1] += bperm(ss[1], lane ^ o); }
#pragma unroll
            for (int q = 0; q < 2; ++q) {
                const int row = rowa + q * rstep;
                if (row < MTOT) {
                    const float r = rsqrtf(ss[q] * (1.f / DM) + 1e-6f);
#pragma unroll
                    for (int i = 0; i < 4; ++i) {
                        const float4 wv4 = *(const float4*)(w + i * 256 + lane * 4);
                        u32x2 o; o[0] = pk_bf16(v[q][i].x * r * wv4.x, v[q][i].y * r * wv4.y); o[1] = pk_bf16(v[q][i].z * r * wv4.z, v[q][i].w * r * wv4.w);
                        *(u32x2*)(xn + (size_t)row * DM + i * 256 + lane * 4) = o;
                    }
                }
            }
        }
    }
}

__device__ __forceinline__ void norm_pass(const Params& p, bool res_from_input, const float* wpost, float scale, const float* wnext, int row_begin, bf16_t* xn) {
    const int tq = tid_l(), lane = tq & 63, wv = __builtin_amdgcn_readfirstlane(tq >> 6);
    const bf16_t* d = (const bf16_t*)(p.ws + WS_D);
    float* y = p.out + O_Y;
    const int rstep = gdim_l() * 8;
    for (int rowa = row_begin + bid_l() * 8 + wv; rowa < MTOT; rowa += 2 * rstep) {
        float4 v[2][4], x[2][4]; float ss[2] = {0.f, 0.f};
#pragma unroll
        for (int q = 0; q < 2; ++q) {
            const int row = rowa + q * rstep;
            if (row < MTOT) {
                const float* rr = res_from_input ? (row < MP ? p.in[0] + (size_t)row * DM : p.in[1] + (size_t)(row - MP) * DM) : y + (size_t)row * DM;
                const bf16_t* dr = d + (size_t)row * DM;
#pragma unroll
                for (int i = 0; i < 4; ++i) { const u32x2 dv = *(const u32x2*)(dr + i * 256 + lane * 4); v[q][i] = make_float4(bflo(dv[0]), bfhi(dv[0]), bflo(dv[1]), bfhi(dv[1])); x[q][i] = *(const float4*)(rr + i * 256 + lane * 4); }
            } else {
#pragma unroll
                for (int i = 0; i < 4; ++i) { v[q][i] = make_float4(0.f, 0.f, 0.f, 0.f); x[q][i] = make_float4(0.f, 0.f, 0.f, 0.f); }
            }
        }
#pragma unroll
        for (int q = 0; q < 2; ++q)
#pragma unroll
            for (int i = 0; i < 4; ++i) ss[q] += v[q][i].x * v[q][i].x + v[q][i].y * v[q][i].y + v[q][i].z * v[q][i].z + v[q][i].w * v[q][i].w;
#pragma unroll
        for (int o = 32; o; o >>= 1) { ss[0] += bperm(ss[0], lane ^ o); ss[1] += bperm(ss[1], lane ^ o); }
        float ss2[2] = {0.f, 0.f};
#pragma unroll
        for (int q = 0; q < 2; ++q) {
            const int row = rowa + q * rstep;
            const float r = rsqrtf(ss[q] * (1.f / DM) + 1e-6f) * scale;
#pragma unroll
            for (int i = 0; i < 4; ++i) {
                const float4 w4 = *(const float4*)(wpost + i * 256 + lane * 4);
                x[q][i].x += v[q][i].x * r * w4.x; x[q][i].y += v[q][i].y * r * w4.y; x[q][i].z += v[q][i].z * r * w4.z; x[q][i].w += v[q][i].w * r * w4.w;
                ss2[q] += x[q][i].x * x[q][i].x + x[q][i].y * x[q][i].y + x[q][i].z * x[q][i].z + x[q][i].w * x[q][i].w;
                if (row < MTOT) *(float4*)(y + (size_t)row * DM + i * 256 + lane * 4) = x[q][i];
            }
        }
        if (wnext) {
#pragma unroll
            for (int o = 32; o; o >>= 1) { ss2[0] += bperm(ss2[0], lane ^ o); ss2[1] += bperm(ss2[1], lane ^ o); }
#pragma unroll
            for (int q = 0; q < 2; ++q) {
                const int row = rowa + q * rstep;
                const float r2 = rsqrtf(ss2[q] * (1.f / DM) + 1e-6f);
                if (row < MTOT) {
#pragma unroll
                    for (int i = 0; i < 4; ++i) {
                        const float4 w4 = *(const float4*)(wnext + i * 256 + lane * 4);
                        u32x2 o; o[0] = pk_bf16(x[q][i].x * r2 * w4.x, x[q][i].y * r2 * w4.y); o[1] = pk_bf16(x[q][i].z * r2 * w4.z, x[q][i].w * r2 * w4.w);
                        *(u32x2*)(xn + (size_t)row * DM + i * 256 + lane * 4) = o;
                    }
                }
            }
        }
    }
}

struct RgPre { u32x4 raw[7]; };
__device__ __forceinline__ void rg_prefetch(const Params& p, int T, int hb, RgPre& pre) {
    const int tid = tid_l();
    const bf16_t* proj = (const bf16_t*)(p.ws + WS_PROJ);
    int vo = hb * 128 + (tid & 15) * 8; asm volatile("" : "+v"(vo));
    const int row0 = T * 128 + (tid >> 4) * 4 - 3;
#pragma unroll
    for (int r = 0; r < 7; ++r) { const int row = row0 + r < 0 ? 0 : row0 + r; pre.raw[r] = *(const u32x4*)(proj + (size_t)row * LDP + vo); }
}
__device__ __forceinline__ void rg_item(const Params& p, LAS unsigned char* lds, int T, int hb, RgPre& pre, int Tn, int hbn) {
    const int tid = tid_l(), lane = tid & 63, w = __builtin_amdgcn_readfirstlane(tid >> 6), fr = lane & 15, fq = lane >> 4;
    const int r0 = T * 128; const bool isS = r0 >= MP;
    bf16_t* proj = (bf16_t*)(p.ws + WS_PROJ);
    LAS bf16_t* As = (LAS bf16_t*)lds;
    const bf16_t* ga0 = (const bf16_t*)(p.ws + WS_GA) + hb * 16384;
    const bf16_t* gx0 = (const bf16_t*)(p.ws + WS_GX) + hb * 16384;
    bf16x8 bfa[4], bfx[4];
#pragma unroll
    for (int ks = 0; ks < 4; ++ks) {
        bfa[ks] = *(const bf16x8*)(ga0 + (w * 16 + fr) * 128 + ks * 32 + fq * 8);
        bfx[ks] = *(const bf16x8*)(gx0 + (w * 16 + fr) * 128 + ks * 32 + fq * 8);
    }
    {
        const int cgp = tid & 15, t0 = (tid >> 4) * 4;
        const int ch0 = hb * 128 + cgp * 8;
        float f[7][8];
#pragma unroll
        for (int r = 0; r < 7; ++r) unpack8(pre.raw[r], f[r]);
        if (!isS) {
            if ((T & 15) == 0 && t0 == 0) {
#pragma unroll
                for (int r = 0; r < 3; ++r)
#pragma unroll
                    for (int e = 0; e < 8; ++e) f[r][e] = 0.f;
            }
        } else {
            const int seq = ((r0 - MP) >> 2) + (tid >> 4);
#pragma unroll
            for (int r = 0; r < 3; ++r) {
                const float* sp = p.in[3] + ((size_t)seq * 3 + r) * 1024 + ch0;
                const float4 a = *(const float4*)sp, b = *(const float4*)(sp + 4);
                f[r][0] = a.x; f[r][1] = a.y; f[r][2] = a.z; f[r][3] = a.w; f[r][4] = b.x; f[r][5] = b.y; f[r][6] = b.z; f[r][7] = b.w;
            }
        }
        float bias[8];
        { const float4 a = *(const float4*)(p.in[15] + ch0), b = *(const float4*)(p.in[15] + ch0 + 4);
          bias[0] = a.x; bias[1] = a.y; bias[2] = a.z; bias[3] = a.w; bias[4] = b.x; bias[5] = b.y; bias[6] = b.z; bias[7] = b.w; }
        float av[4][8];
#pragma unroll
        for (int r = 0; r < 4; ++r)
#pragma unroll
            for (int e = 0; e < 8; ++e) av[r][e] = bias[e];
#pragma unroll
        for (int k = 0; k < 4; ++k) {
            const float4 a = *(const float4*)(p.in[14] + k * 1024 + ch0), b = *(const float4*)(p.in[14] + k * 1024 + ch0 + 4);
            const float wk[8] = {a.x, a.y, a.z, a.w, b.x, b.y, b.z, b.w};
#pragma unroll
            for (int r = 0; r < 4; ++r)
#pragma unroll
                for (int e = 0; e < 8; ++e) av[r][e] += wk[e] * f[r + k][e];
        }
#pragma unroll
        for (int r = 0; r < 4; ++r) *(LAS u32x4*)(As + (t0 + r) * 136 + cgp * 8) = pack8(av[r]);
    }
    rg_prefetch(p, Tn, hbn, pre);
    lds_barrier();
    f32x4 aa[8], ax[8];
    __builtin_amdgcn_s_setprio(1);
#pragma unroll
    for (int m = 0; m < 8; ++m) {
        aa[m] = (f32x4){0.f, 0.f, 0.f, 0.f}; ax[m] = (f32x4){0.f, 0.f, 0.f, 0.f};
#pragma unroll
        for (int ks = 0; ks < 4; ++ks) {
            const bf16x8 af = *(const LAS bf16x8*)(As + (m * 16 + fr) * 136 + ks * 32 + fq * 8);
            aa[m] = __builtin_amdgcn_mfma_f32_16x16x32_bf16(af, bfa[ks], aa[m], 0, 0, 0);
            ax[m] = __builtin_amdgcn_mfma_f32_16x16x32_bf16(af, bfx[ks], ax[m], 0, 0, 0);
        }
    }
    __builtin_amdgcn_s_setprio(0);
    const int ch = hb * 128 + w * 16 + fr;
    const float bav = p.in[17][ch], bxv = p.in[19][ch];
    const float sp8 = -8.f * softplusf_(-p.in[20][ch]);
    if (!isS) {
        unsigned* rgt = (unsigned*)(p.ws + WS_D);
        float At = 1.f, Ht = 0.f;
#pragma unroll
        for (int m = 0; m < 8; ++m) {
            float A4 = 1.f, H4 = 0.f;
#pragma unroll
            for (int j = 0; j < 4; ++j) {
                const int t = m * 16 + fq * 4 + j;
                const float xcv = bf2f(As[t * 136 + w * 16 + fr]);
                const float gav = sigmoidf_(aa[m][j] + bav), gxv = sigmoidf_(ax[m][j] + bxv);
                float la = bf2f(f2bf(sp8 * gav));
                float a = __expf(la);
                float mult = sqrtf(fmaxf(1.f - a * a, 0.f));
                if ((T & 15) == 0 && t == 0) { a = 0.f; la = -__builtin_inff(); mult = 1.f; }
                const float uu = bf2f(f2bf(xcv * gxv * mult));
                __builtin_nontemporal_store(pk_bf16(la, uu), rgt + (size_t)(r0 + t) * 1024 + ch);
                H4 = a * H4 + uu; A4 *= a;
            }
            { const float Ao = bperm(A4, lane ^ 16), Ho = bperm(H4, lane ^ 16);
              if (fq & 1) { H4 = A4 * Ho + H4; } else { H4 = Ao * H4 + Ho; } A4 *= Ao; }
            { const float Ao = bperm(A4, lane ^ 32), Ho = bperm(H4, lane ^ 32);
              if (fq & 2) { H4 = A4 * Ho + H4; } else { H4 = Ao * H4 + Ho; } A4 *= Ao; }
            Ht = A4 * Ht + H4; At *= A4;
        }
        if (fq == 0) { float2* tot = (float2*)(p.ws + WS_RGTOT); tot[(size_t)T * 1024 + ch] = make_float2(At, Ht); }
    } else {
        bf16_t gv[8][4]; float h0v[8];
        {
            int vo = (fq * 4) * LDP + 1024 + ch; asm volatile("" : "+v"(vo));
            const bf16_t* gb = proj + (size_t)r0 * LDP;
#pragma unroll
            for (int m = 0; m < 8; ++m) {
                h0v[m] = p.in[2][(size_t)(((r0 - MP) >> 2) + m * 4 + fq) * 1024 + ch];
#pragma unroll
                for (int j = 0; j < 4; ++j) gv[m][j] = gb[vo + (m * 16 + j) * LDP];
            }
        }
#pragma unroll
        for (int m = 0; m < 8; ++m) {
            const int seq = ((r0 - MP) >> 2) + m * 4 + fq;
            float h = h0v[m];
#pragma unroll
            for (int j = 0; j < 4; ++j) {
                const int t = m * 16 + fq * 4 + j;
                const float xcv = bf2f(As[t * 136 + w * 16 + fr]);
                const float gav = sigmoidf_(aa[m][j] + bav), gxv = sigmoidf_(ax[m][j] + bxv);
                const float la = sp8 * gav;
                const float a = __expf(la);
                const float mult = sqrtf(fmaxf(1.f - a * a, 0.f));
                h = a * h + xcv * gxv * mult;
                proj[(size_t)(r0 + t) * LDP + 1024 + ch] = f2bf(h * geluf_(bf2f(gv[m][j])));
            }
            p.out[O_SRGH + (size_t)seq * 1024 + ch] = h;
        }
    }
}


__device__ __forceinline__ void phase_bc(const Params& p) {
    const int tid = tid_l(), G = gdim_l(), bid = bid_l();
    const bf16_t* proj = (const bf16_t*)(p.ws + WS_PROJ);
    const int cgp = tid & 255, half = tid >> 8, ch0 = cgp * 8;
    float wk[4][8], bias[8];
#pragma unroll
    for (int k = 0; k < 4; ++k) {
        const float4 a = *(const float4*)(p.in[21] + k * 4096 + 2048 + ch0), c = *(const float4*)(p.in[21] + k * 4096 + 2048 + ch0 + 4);
        wk[k][0] = a.x; wk[k][1] = a.y; wk[k][2] = a.z; wk[k][3] = a.w; wk[k][4] = c.x; wk[k][5] = c.y; wk[k][6] = c.z; wk[k][7] = c.w;
    }
    { const float4 a = *(const float4*)(p.in[22] + 2048 + ch0), c = *(const float4*)(p.in[22] + 2048 + ch0 + 4);
      bias[0] = a.x; bias[1] = a.y; bias[2] = a.z; bias[3] = a.w; bias[4] = c.x; bias[5] = c.y; bias[6] = c.z; bias[7] = c.w; }
    u32x4 cur[11], nxt[11];
#define BC_LOAD(dst_, j4_) do { \
        const int _it = G == 256 ? (bid & 7) * 128 + (bid >> 3) + 32 * (j4_) : bid + (j4_) * G; \
        const int _row0 = _it * 16 + half * 8 - 3; \
        int _vo = ch0; asm volatile("" : "+v"(_vo)); \
        _Pragma("unroll") for (int r = 0; r < 11; ++r) { const int _row = _row0 + r < 0 ? 0 : _row0 + r; dst_[r] = *(const u32x4*)(proj + (size_t)_row * LDP + 6144 + _vo); } \
    } while (0)
    if (bid < 1024) BC_LOAD(cur, 0);
    for (int j4 = 0; j4 * G + bid < 1024; ++j4) {
        const int it = G == 256 ? (bid & 7) * 128 + (bid >> 3) + 32 * j4 : bid + j4 * G;
        const int row0 = it * 16 + half * 8, b = row0 >> 11, tl = row0 & 2047;
        int vo = ch0; asm volatile("" : "+v"(vo));
        { const int jn = (j4 + 1) * G + bid < 1024 ? j4 + 1 : j4; BC_LOAD(nxt, jn); }
        float o[8][8];
#pragma unroll
        for (int r = 0; r < 8; ++r)
#pragma unroll
            for (int e = 0; e < 8; ++e) o[r][e] = bias[e];
#pragma unroll
        for (int rr = 0; rr < 11; ++rr) {
            float f[8]; unpack8(cur[rr], f);
            if (rr < 3 && tl == 0) {
#pragma unroll
                for (int e = 0; e < 8; ++e) f[e] = 0.f;
            }
#pragma unroll
            for (int k = 0; k < 4; ++k) {
                const int r = rr - k;
                if (r >= 0 && r < 8) {
#pragma unroll
                    for (int e = 0; e < 8; ++e) o[r][e] += wk[k][e] * f[e];
                }
            }
        }
        bf16_t* dst = bc_base(p.ws, b) + (size_t)tl * 2048;
#pragma unroll
        for (int r = 0; r < 8; ++r) {
#pragma unroll
            for (int e = 0; e < 8; ++e) o[r][e] = siluf_(o[r][e]);
            *(u32x4*)(dst + (vo + r * 2048)) = pack8(o[r]);
        }
#pragma unroll
        for (int r = 0; r < 11; ++r) cur[r] = nxt[r];
    }
#undef BC_LOAD
}

__device__ __forceinline__ void conv4_s(const Params& p, const bf16_t* proj, int seq, int rbase, int cidx, float* o) {
    float xin[7];
#pragma unroll
    for (int k = 0; k < 3; ++k) xin[k] = p.in[5][((size_t)seq * 3 + k) * 4096 + cidx];
#pragma unroll
    for (int j = 0; j < 4; ++j) xin[3 + j] = bf2f(proj[(size_t)(rbase + j) * LDP + 4096 + cidx]);
    const float w0 = p.in[21][cidx], w1 = p.in[21][4096 + cidx], w2 = p.in[21][8192 + cidx], w3 = p.in[21][12288 + cidx], b = p.in[22][cidx];
#pragma unroll
    for (int j = 0; j < 4; ++j) o[j] = siluf_(b + w0 * xin[j] + w1 * xin[j + 1] + w2 * xin[j + 2] + w3 * xin[j + 3]);
}
__device__ __forceinline__ void ssd_s_item(const Params& p, LAS float* wl, int seq, int h) {
    const int lane = tid_l() & 63, g = h >> 2;
    const int rbase = MP + seq * 4;
    const int pl = lane >> 4, nl = lane & 15;
    const float* h0p = p.in[4] + ((size_t)seq * 32 + h) * 8192;
    f32x4 hA[4], hB[4];
    { int vo = pl * 128 + nl * 8; asm volatile("" : "+v"(vo));
#pragma unroll
      for (int k = 0; k < 4; ++k) { hA[k] = __builtin_nontemporal_load((const f32x4*)(h0p + vo + k * 512)); hB[k] = __builtin_nontemporal_load((const f32x4*)(h0p + vo + k * 512 + 4)); } }
    bf16_t* proj = (bf16_t*)(p.ws + WS_PROJ);
    const float* DT = (const float*)(p.ws + WS_DT);
    LAS float* xs = wl; LAS float* Bl = wl + 256; LAS float* Cl = wl + 768; LAS float* yo = wl + 1280;
    float xv[4], b0[4], b1[4], c0[4], c1[4];
    conv4_s(p, proj, seq, rbase, h * 64 + lane, xv);
    conv4_s(p, proj, seq, rbase, 2048 + g * 128 + lane, b0);
    conv4_s(p, proj, seq, rbase, 2048 + g * 128 + 64 + lane, b1);
    conv4_s(p, proj, seq, rbase, 3072 + g * 128 + lane, c0);
    conv4_s(p, proj, seq, rbase, 3072 + g * 128 + 64 + lane, c1);
    const float Ah = -__expf(p.in[24][h]), Dh = p.in[25][h];
    float dtv[4], acs[4];
    { float s = 0.f;
#pragma unroll
      for (int j = 0; j < 4; ++j) { dtv[j] = DT[(size_t)(rbase + j) * 32 + h]; s += dtv[j] * Ah; acs[j] = s; } }
#pragma unroll
    for (int j = 0; j < 4; ++j) { xs[j * 64 + lane] = xv[j]; Bl[j * 128 + lane] = b0[j]; Bl[j * 128 + 64 + lane] = b1[j]; Cl[j * 128 + lane] = c0[j]; Cl[j * 128 + 64 + lane] = c1[j]; }
    float yd[4];
#pragma unroll
    for (int i = 0; i < 4; ++i) {
        yd[i] = 0.f;
#pragma unroll
        for (int j = 0; j <= i; ++j) {
            const float cb = wave_sum(c0[i] * b0[j] + c1[i] * b1[j], lane);
            yd[i] += cb * __expf(acs[i] - acs[j]) * dtv[j] * xv[j];
        }
    }
    asm volatile("s_waitcnt lgkmcnt(0)" ::: "memory");
    __builtin_amdgcn_wave_barrier();
    float Cr[4][8], Bw[4][8];
#pragma unroll
    for (int i = 0; i < 4; ++i) {
        const float wj = __expf(acs[3] - acs[i]) * dtv[i];
#pragma unroll
        for (int e = 0; e < 8; ++e) { Cr[i][e] = Cl[i * 128 + nl * 8 + e]; Bw[i][e] = Bl[i * 128 + nl * 8 + e] * wj; }
    }
    const float dec = __expf(acs[3]);
    float* hop = p.out + O_SSSD + ((size_t)seq * 32 + h) * 8192;
#pragma unroll
    for (int hf = 0; hf < 4; ++hf) {
        f32x4 nA[4], nB[4];
        if (hf < 3) {
            int vo = pl * 128 + nl * 8 + (hf + 1) * 2048; asm volatile("" : "+v"(vo));
#pragma unroll
            for (int k = 0; k < 4; ++k) { nA[k] = __builtin_nontemporal_load((const f32x4*)(h0p + vo + k * 512)); nB[k] = __builtin_nontemporal_load((const f32x4*)(h0p + vo + k * 512 + 4)); }
        }
#pragma unroll
        for (int k = 0; k < 4; ++k) {
            const int pp = pl + 4 * (hf * 4 + k);
            const f32x4 ha = hA[k], hb = hB[k];
            float part[4];
#pragma unroll
            for (int i = 0; i < 4; ++i) {
                float s = 0.f;
#pragma unroll
                for (int e = 0; e < 4; ++e) s += Cr[i][e] * ha[e] + Cr[i][4 + e] * hb[e];
                s += bperm(s, lane ^ 1); s += bperm(s, lane ^ 2); s += bperm(s, lane ^ 4); s += bperm(s, lane ^ 8);
                part[i] = s;
            }
            if (nl == 0) {
#pragma unroll
                for (int i = 0; i < 4; ++i) yo[i * 64 + pp] = part[i] * __expf(acs[i]);
            }
            float xj[4];
#pragma unroll
            for (int j = 0; j < 4; ++j) xj[j] = xs[j * 64 + pp];
            f32x4 na, nb;
#pragma unroll
            for (int e = 0; e < 4; ++e) {
                float s0 = dec * ha[e], s1 = dec * hb[e];
#pragma unroll
                for (int j = 0; j < 4; ++j) { s0 += Bw[j][e] * xj[j]; s1 += Bw[j][4 + e] * xj[j]; }
                na[e] = s0; nb[e] = s1;
            }
            __builtin_nontemporal_store(na, (f32x4*)(hop + pp * 128 + nl * 8)); __builtin_nontemporal_store(nb, (f32x4*)(hop + pp * 128 + nl * 8 + 4));
        }
        if (hf < 3) {
#pragma unroll
            for (int k = 0; k < 4; ++k) { hA[k] = nA[k]; hB[k] = nB[k]; }
        }
    }
    asm volatile("s_waitcnt lgkmcnt(0)" ::: "memory");
    __builtin_amdgcn_wave_barrier();
#pragma unroll
    for (int i = 0; i < 4; ++i) {
        bf16_t* zp = proj + (size_t)(rbase + i) * LDP + 2048 + h * 64 + lane;
        const float y = yd[i] + yo[i * 64 + lane] + Dh * xv[i];
        *zp = f2bf(y * siluf_(bf2f(*zp)));
    }
    asm volatile("s_waitcnt lgkmcnt(0)" ::: "memory");
    __builtin_amdgcn_wave_barrier();
}

constexpr int SP_CS = 0, SP_BS = 34816, SP_BT = 69632, SP_XT = 104448, SP_SS = 121856, SP_SC = 139264, SP_WT = 142336;


struct SsdPre { u32x4 c[4], b[4], x[5]; u32x2 z[4]; float d0, d1; };

template <int NROW>
__device__ __forceinline__ void ssd_conv(const u32x4* raw, const LAS float* wts, float (&o)[NROW][8]) {
#pragma unroll
    for (int r = 0; r < NROW; ++r)
#pragma unroll
        for (int e = 0; e < 8; ++e) o[r][e] = wts[4 * 320 + e];
#pragma unroll
    for (int k = 0; k < 4; ++k) {
        float wk[8];
#pragma unroll
        for (int e = 0; e < 8; ++e) wk[e] = wts[k * 320 + e];
#pragma unroll
        for (int r = 0; r < NROW; ++r) {
            float f[8]; unpack8(raw[r + k], f);
#pragma unroll
            for (int e = 0; e < 8; ++e) o[r][e] += wk[e] * f[e];
        }
    }
#pragma unroll
    for (int r = 0; r < NROW; ++r)
#pragma unroll
        for (int e = 0; e < 8; ++e) o[r][e] = siluf_(o[r][e]);
}

__device__ __forceinline__ void ssd_p_item(const Params& p, LAS unsigned char* lds, int b, int h) {
    const int tid = tid_l(), lane = tid & 63, w = __builtin_amdgcn_readfirstlane(tid >> 6), fr = lane & 15, fq = lane >> 4, g = h >> 2;
    LAS bf16_t* Cs = (LAS bf16_t*)(lds + SP_CS); LAS bf16_t* Bs = (LAS bf16_t*)(lds + SP_BS); LAS bf16_t* Bt = (LAS bf16_t*)(lds + SP_BT);
    LAS bf16_t* Xt = (LAS bf16_t*)(lds + SP_XT); LAS bf16_t* Ss = (LAS bf16_t*)(lds + SP_SS);
    LAS float* scb = (LAS float*)(lds + SP_SC);
    LAS float* wts = (LAS float*)(lds + SP_WT);
    bf16_t* proj = (bf16_t*)(p.ws + WS_PROJ);
    const float* DT = (const float*)(p.ws + WS_DT);
    const float Ah = -__expf(p.in[24][h]), Dh = p.in[25][h];
    const bf16_t* bcimg = bc_base(p.ws, b);
    const int cg16 = (w & 3) * 4 + (lane & 3), t0 = ((w >> 2) * 16 + (lane >> 2)) * 4, n8 = cg16 * 8;
    const int cg8 = (w & 3) * 2 + (lane & 1), t0x = ((w >> 2) * 32 + (lane >> 1)) * 2, p8 = cg8 * 8;
    SsdPre pre;
    const u32x4 zero4 = {0u, 0u, 0u, 0u};
#define SSD_PREFETCH_(c_, FIRST) do { \
        const int _r0 = b * 2048 + (c_) * 128; \
        const bf16_t* _rb3 = proj + ((long)_r0 - 3) * LDP + 4096; \
        const bf16_t* _bc = bcimg + (size_t)((c_) * 128) * 2048; \
        int _vc = t0 * 2048 + 1024 + g * 128 + n8, _vx = t0x * LDP + h * 64 + p8; \
        asm volatile("" : "+v"(_vc), "+v"(_vx)); \
        _Pragma("unroll") for (int r = 0; r < 4; ++r) { pre.c[r] = *(const u32x4*)(_bc + (_vc + r * 2048)); pre.b[r] = *(const u32x4*)(_bc + (_vc + r * 2048 - 1024)); } \
        _Pragma("unroll") for (int r = 0; r < 5; ++r) { \
            if (FIRST && t0x - 3 + r < 0) pre.x[r] = zero4; else pre.x[r] = *(const u32x4*)(_rb3 + (_vx + r * LDP)); } \
        { int _vd = 2 * lane * 32 + h; asm volatile("" : "+v"(_vd)); const float* _dp = DT + (size_t)_r0 * 32; pre.d0 = _dp[_vd]; pre.d1 = _dp[_vd + 32]; } \
    } while (0)
#define SSD_PREFETCH_Z(c_) do { \
        const bf16_t* _zb = proj + (size_t)(b * 2048 + (c_) * 128) * LDP + 2048 + h * 64; \
        int _vz = (16 * w + fr) * LDP + fq * 4; asm volatile("" : "+v"(_vz)); \
        _Pragma("unroll") for (int pt = 0; pt < 4; ++pt) pre.z[pt] = *(const u32x2*)(_zb + _vz + pt * 16); \
    } while (0)
    pre.d0 = 0.f; pre.d1 = 0.f;
    SSD_PREFETCH_(0, true);
    SSD_PREFETCH_Z(0);
    lds_barrier();
    for (int i = tid; i < 1600; i += 512) {
        const int k = i / 320, c = i % 320;
        const int ch = c < 64 ? h * 64 + c : (c < 192 ? 2048 + g * 128 + (c - 64) : 3072 + g * 128 + (c - 192));
        wts[i] = k < 4 ? p.in[21][k * 4096 + ch] : p.in[22][ch];
    }
    for (int i = tid; i < 64 * 136 / 2; i += 512) ((LAS unsigned*)Ss)[i] = 0u;
    f32x4 accS[4];
#pragma unroll
    for (int pt = 0; pt < 4; ++pt) accS[pt] = (f32x4){0.f, 0.f, 0.f, 0.f};
#define SSD_SCAN(par) do { if (w == 0) { \
        LAS float* _a = scb + (par) * 384; \
        const float d0 = pre.d0, d1 = pre.d1; const float a0 = d0 * Ah, a1 = d1 * Ah; \
        float s = a0 + a1; \
        _Pragma("unroll") for (int o = 1; o < 64; o <<= 1) { const float tmp = bperm(s, lane - o); if (lane >= o) s += tmp; } \
        const float tot = bperm(s, 63); \
        _a[2 * lane] = s - a1; _a[2 * lane + 1] = s; _a[128 + 2 * lane] = d0; _a[128 + 2 * lane + 1] = d1; \
        _a[256 + 2 * lane] = __expf(tot - (s - a1)) * d0; _a[256 + 2 * lane + 1] = __expf(tot - s) * d1; } } while (0)
    SSD_SCAN(0);
    for (int c = 0; c < 16; ++c) {
        LAS float* acs = scb + (c & 1) * 384; LAS float* dtv = acs + 128; LAS float* wjs = acs + 256;
        const int r0 = b * 2048 + c * 128;
        int lane_c = lane; asm volatile("" : "+v"(lane_c));
        const int lane = lane_c, fr = lane & 15, fq = lane >> 4;
        const int cg16 = (w & 3) * 4 + (lane & 3), t0 = ((w >> 2) * 16 + (lane >> 2)) * 4, n8 = cg16 * 8;
        const int cg8 = (w & 3) * 2 + (lane & 1), t0x = ((w >> 2) * 32 + (lane >> 1)) * 2, p8 = cg8 * 8;
        lds_barrier();
#pragma unroll
        for (int pt = 0; pt < 4; ++pt) {
            u32x2 o; o[0] = pk_bf16(accS[pt][0], accS[pt][1]); o[1] = pk_bf16(accS[pt][2], accS[pt][3]);
            *(LAS u32x2*)(Ss + (pt * 16 + fr) * 136 + 16 * w + fq * 4) = o;
        }
        {
            float wj[4];
#pragma unroll
            for (int r = 0; r < 4; ++r) { *(LAS u32x4*)(Cs + (t0 + r) * 136 + n8) = pre.c[r]; *(LAS u32x4*)(Bs + (t0 + r) * 136 + n8) = pre.b[r]; wj[r] = wjs[t0 + r]; }
            float o[4][8];
#pragma unroll
            for (int r = 0; r < 4; ++r) unpack8(pre.b[r], o[r]);
#pragma unroll
            for (int e = 0; e < 8; ++e) {
                u32x2 v; v[0] = pk_bf16(o[0][e] * wj[0], o[1][e] * wj[1]); v[1] = pk_bf16(o[2][e] * wj[2], o[3][e] * wj[3]);
                *(LAS u32x2*)(Bt + (n8 + e) * 136 + (t0 ^ ((cg16 & 3) << 3))) = v;
            }
        }
        {
            float o[2][8];
            ssd_conv<2>(pre.x, wts + p8, o);
#pragma unroll
            for (int e = 0; e < 8; ++e) *(LAS unsigned*)(Xt + (p8 + e) * 136 + t0x) = pk_bf16(o[0][e], o[1][e]);
        }
        { const int cn = c + 1 < 16 ? c + 1 : 15; SSD_PREFETCH_(cn, false); }
        lds_barrier();
        bf16x8 cfr[4];
#pragma unroll
        for (int ks = 0; ks < 4; ++ks) cfr[ks] = *(const LAS bf16x8*)(Cs + (16 * w + fr) * 136 + ks * 32 + fq * 8);
        f32x4 cb[8];
        __builtin_amdgcn_s_setprio(1);
#pragma unroll
        for (int jt = 0; jt < 8; ++jt) {
            cb[jt] = (f32x4){0.f, 0.f, 0.f, 0.f};
            if (jt <= w) {
#pragma unroll
                for (int ks = 0; ks < 4; ++ks) {
                    const bf16x8 bfr = *(const LAS bf16x8*)(Bs + (jt * 16 + fr) * 136 + ks * 32 + fq * 8);
                    cb[jt] = __builtin_amdgcn_mfma_f32_16x16x32_bf16(bfr, cfr[ks], cb[jt], 0, 0, 0);
                }
            }
        }
        __builtin_amdgcn_s_setprio(0);
        {
            const int i = 16 * w + fr;
            const float ai = acs[i];
#pragma unroll
            for (int jt = 0; jt < 8; ++jt) {
                const int j0 = jt * 16 + fq * 4;
                const f32x4 aj = *(const LAS f32x4*)(acs + j0), dj = *(const LAS f32x4*)(dtv + j0);
                float v[4];
#pragma unroll
                for (int r = 0; r < 4; ++r) v[r] = (jt <= w && j0 + r <= i) ? cb[jt][r] * __expf(ai - aj[r]) * dj[r] : 0.f;
                u32x2 o; o[0] = pk_bf16(v[0], v[1]); o[1] = pk_bf16(v[2], v[3]);
                *(LAS u32x2*)(Cs + i * 136 + j0) = o;
            }
        }
        asm volatile("s_waitcnt lgkmcnt(0)" ::: "memory");
        __builtin_amdgcn_wave_barrier();
        f32x4 yd[4], yo[4];
#pragma unroll
        for (int pt = 0; pt < 4; ++pt) { yd[pt] = (f32x4){0.f, 0.f, 0.f, 0.f}; yo[pt] = (f32x4){0.f, 0.f, 0.f, 0.f}; }
        __builtin_amdgcn_s_setprio(1);
#pragma unroll
        for (int ks = 0; ks < 4; ++ks) {
            if (ks <= (w >> 1)) {
                const bf16x8 wfr = *(const LAS bf16x8*)(Cs + (16 * w + fr) * 136 + ks * 32 + fq * 8);
#pragma unroll
                for (int pt = 0; pt < 4; ++pt) {
                    const bf16x8 xfr = *(const LAS bf16x8*)(Xt + (pt * 16 + fr) * 136 + ks * 32 + fq * 8);
                    yd[pt] = __builtin_amdgcn_mfma_f32_16x16x32_bf16(xfr, wfr, yd[pt], 0, 0, 0);
                }
            }
        }
#pragma unroll
        for (int ks = 0; ks < 4; ++ks)
#pragma unroll
            for (int pt = 0; pt < 4; ++pt) {
                const bf16x8 sfr = *(const LAS bf16x8*)(Ss + (pt * 16 + fr) * 136 + ks * 32 + fq * 8);
                yo[pt] = __builtin_amdgcn_mfma_f32_16x16x32_bf16(sfr, cfr[ks], yo[pt], 0, 0, 0);
            }
        __builtin_amdgcn_s_setprio(0);
        {
            bf16_t* zb = proj + (size_t)r0 * LDP + 2048 + h * 64;
            int vz = (16 * w + fr) * LDP + fq * 4; asm volatile("" : "+v"(vz));
            const int i = 16 * w + fr;
            const float ea = __expf(acs[i]);
#pragma unroll
            for (int pt = 0; pt < 4; ++pt) {
                const float z0 = bflo(pre.z[pt][0]), z1 = bfhi(pre.z[pt][0]), z2 = bflo(pre.z[pt][1]), z3 = bfhi(pre.z[pt][1]);
                const int pc = pt * 16 + fq * 4;
                const float y0 = yd[pt][0] + ea * yo[pt][0] + Dh * bf2f(Xt[(pc + 0) * 136 + i]);
                const float y1 = yd[pt][1] + ea * yo[pt][1] + Dh * bf2f(Xt[(pc + 1) * 136 + i]);
                const float y2 = yd[pt][2] + ea * yo[pt][2] + Dh * bf2f(Xt[(pc + 2) * 136 + i]);
                const float y3 = yd[pt][3] + ea * yo[pt][3] + Dh * bf2f(Xt[(pc + 3) * 136 + i]);
                u32x2 o; o[0] = pk_bf16(y0 * siluf_(z0), y1 * siluf_(z1)); o[1] = pk_bf16(y2 * siluf_(z2), y3 * siluf_(z3));
                *(u32x2*)(zb + vz + pt * 16) = o;
            }
        }
        { const int cn = c + 1 < 16 ? c + 1 : 15; SSD_PREFETCH_Z(cn); }
        {
            const float dec = __expf(acs[127]);
            __builtin_amdgcn_s_setprio(1);
            bf16x8 btf[4];
#pragma unroll
            for (int ks = 0; ks < 4; ++ks) btf[ks] = *(const LAS bf16x8*)(Bt + (16 * w + fr) * 136 + ((ks * 32 + fq * 8) ^ ((((16 * w + fr) >> 3) & 3) << 3)));
#pragma unroll
            for (int pt = 0; pt < 4; ++pt) {
                accS[pt] *= dec;
#pragma unroll
                for (int ks = 0; ks < 4; ++ks) {
                    const bf16x8 xfr = *(const LAS bf16x8*)(Xt + (pt * 16 + fr) * 136 + ks * 32 + fq * 8);
                    accS[pt] = __builtin_amdgcn_mfma_f32_16x16x32_bf16(btf[ks], xfr, accS[pt], 0, 0, 0);
                }
            }
        }
        __builtin_amdgcn_s_setprio(0);
        SSD_SCAN((c + 1) & 1);
    }
#undef SSD_SCAN
#undef SSD_PREFETCH_
#undef SSD_PREFETCH_Z
    float* so = p.out + O_PSSD + ((size_t)b * 32 + h) * 8192;
#pragma unroll
    for (int pt = 0; pt < 4; ++pt) __builtin_nontemporal_store(accS[pt], (f32x4*)(so + (pt * 16 + fr) * 128 + 16 * w + fq * 4));
    lds_barrier();
}

__device__ __forceinline__ void phase_m1(const Params& p, LAS unsigned char* lds) {
    const int G = gdim_l(), bid = bid_l();
    for (int it = bid; it < 256; it += G) ssd_p_item(p, lds, it & 7, it >> 3);
    __syncthreads();
    const int wv = __builtin_amdgcn_readfirstlane(tid_l() >> 6);
    for (int it = bid * 8 + wv; it < 4096; it += G * 8) ssd_s_item(p, (LAS float*)lds + wv * 1536, it >> 5, it & 31);
}

__device__ __forceinline__ void phase_m3(const Params& p) {
    const int tid = tid_l(), G = gdim_l(), bid = bid_l();
    bf16_t* proj = (bf16_t*)(p.ws + WS_PROJ);
    const unsigned* rgt = (const unsigned*)(p.ws + WS_D);
    const float2* tot = (const float2*)(p.ws + WS_RGTOT);
    for (int it = bid; it < 256; it += G) {
        const int T = it >> 1, ch = (it & 1) * 512 + tid, r0 = T * 128;
        float h = 0.f;
        for (int c = (T & ~15); c < T; ++c) { const float2 ah = tot[(size_t)c * 1024 + ch]; h = ah.x * h + ah.y; }
        const unsigned* rp = rgt + (size_t)r0 * 1024;
        bf16_t* gp = proj + (size_t)r0 * LDP + 1024;
        unsigned pk[3][16]; bf16_t gg[3][16];
        int vo = ch; asm volatile("" : "+v"(vo));
#pragma unroll
        for (int bb = 0; bb < 2; ++bb)
#pragma unroll
            for (int i = 0; i < 16; ++i) { pk[bb][i] = rp[vo + (bb * 16 + i) * 1024]; gg[bb][i] = gp[vo + (bb * 16 + i) * LDP]; }
#pragma unroll
        for (int tb = 0; tb < 8; ++tb) {
            if (tb + 2 < 8) {
#pragma unroll
                for (int i = 0; i < 16; ++i) { pk[(tb + 2) % 3][i] = rp[vo + ((tb + 2) * 16 + i) * 1024]; gg[(tb + 2) % 3][i] = gp[vo + ((tb + 2) * 16 + i) * LDP]; }
            }
#pragma unroll
            for (int i = 0; i < 16; ++i) {
                h = __expf(bflo(pk[tb % 3][i])) * h + bfhi(pk[tb % 3][i]);
                gp[vo + (tb * 16 + i) * LDP] = f2bf(h * geluf_(bf2f(gg[tb % 3][i])));
            }
        }
        if ((T & 15) == 15) p.out[O_PRGH + (size_t)(T >> 4) * 1024 + ch] = h;
    }
    const int gt = bid * 512 + tid, nthr = G * 512;
    for (int i = gt; i < 8 * 3 * 1024; i += nthr) { const int c = i & 1023, k = (i >> 10) % 3, b = i / 3072; p.out[O_PRGC + i] = bf2f(proj[(size_t)(b * 2048 + 2045 + k) * LDP + c]); }
    for (int i = gt; i < 8 * 3 * 4096; i += nthr) { const int c = i & 4095, k = (i >> 12) % 3, b = i / 12288; p.out[O_PSSDC + i] = bf2f(proj[(size_t)(b * 2048 + 2045 + k) * LDP + 4096 + c]); }
    for (int i = gt; i < 128 * 3 * 1024; i += nthr) { const int c = i & 1023, k = (i >> 10) % 3, s = i / 3072; p.out[O_SRGC + i] = bf2f(proj[(size_t)(MP + s * 4 + 1 + k) * LDP + c]); }
    for (int i0 = gt; i0 < 128 * 3 * 4096; i0 += nthr * 4) {
        bf16_t v[4];
#pragma unroll
        for (int u = 0; u < 4; ++u) { const int i = i0 + u * nthr; if (i < 128 * 3 * 4096) { const int c = i & 4095, k = (i >> 12) % 3, s = i / 12288; v[u] = proj[(size_t)(MP + s * 4 + 1 + k) * LDP + 4096 + c]; } else v[u] = 0; }
#pragma unroll
        for (int u = 0; u < 4; ++u) { const int i = i0 + u * nthr; if (i < 128 * 3 * 4096) p.out[O_SSSDC + i] = bf2f(v[u]); }
    }
    {
        const int lane = tid & 63, wv = __builtin_amdgcn_readfirstlane(tid >> 6);
        const int rstep = G * 8;
        for (int rowa = bid * 8 + wv; rowa < MTOT; rowa += 2 * rstep) {
            u32x2 v[2][8]; float ss[2][8];
#pragma unroll
            for (int q = 0; q < 2; ++q) {
                const int row = rowa + q * rstep < MTOT ? rowa + q * rstep : rowa;
                const bf16_t* yp = proj + (size_t)row * LDP + 2048 + lane * 4;
#pragma unroll
                for (int gI = 0; gI < 8; ++gI) v[q][gI] = *(const u32x2*)(yp + gI * 256);
            }
#pragma unroll
            for (int q = 0; q < 2; ++q)
#pragma unroll
                for (int gI = 0; gI < 8; ++gI) { const float f0 = bflo(v[q][gI][0]), f1 = bfhi(v[q][gI][0]), f2 = bflo(v[q][gI][1]), f3 = bfhi(v[q][gI][1]); ss[q][gI] = f0 * f0 + f1 * f1 + f2 * f2 + f3 * f3; }
#pragma unroll
            for (int o = 32; o; o >>= 1)
#pragma unroll
                for (int q = 0; q < 2; ++q)
#pragma unroll
                    for (int gI = 0; gI < 8; ++gI) ss[q][gI] += bperm(ss[q][gI], lane ^ o);
#pragma unroll
            for (int q = 0; q < 2; ++q) {
                if (q == 1 && rowa + rstep >= MTOT) break;
                bf16_t* yp = proj + (size_t)(rowa + q * rstep) * LDP + 2048 + lane * 4;
#pragma unroll
                for (int gI = 0; gI < 8; ++gI) {
                    const float r = rsqrtf(ss[q][gI] * (1.f / 256.f) + 1e-6f);
                    const float4 w4 = *(const float4*)(p.in[26] + gI * 256 + lane * 4);
                    u32x2 o; o[0] = pk_bf16(bflo(v[q][gI][0]) * r * w4.x, bfhi(v[q][gI][0]) * r * w4.y); o[1] = pk_bf16(bflo(v[q][gI][1]) * r * w4.z, bfhi(v[q][gI][1]) * r * w4.w);
                    *(u32x2*)(yp + gI * 256) = o;
                }
            }
        }
    }
}

#define XB_TMO      128
#define XB_XCNT(j)  (256  + 64 * (j))
#define XB_XSUB(j)  (1280 + 64 * (j))
#define XB_XGEN(j)  (2304 + 64 * (j))
#define XB_TOP      3328
#define XB_TOPGEN   3392
#define XCD_BAR_WORDS 3456
#define XB_SPIN_CAP (1u << 18)
__device__ __forceinline__ unsigned xb_ld(unsigned* p)              { return __hip_atomic_load(p, __ATOMIC_RELAXED, __HIP_MEMORY_SCOPE_AGENT); }
__device__ __forceinline__ unsigned xb_add(unsigned* p, unsigned v) { return __hip_atomic_fetch_add(p, v, __ATOMIC_RELAXED, __HIP_MEMORY_SCOPE_AGENT); }
__device__ __forceinline__ unsigned xb_xcc_id() { return (unsigned)__builtin_amdgcn_s_getreg((3 << 11) | 20) & 0xFu; }
#define XB_SPIN(cond, bar) do { unsigned _sp = 0; while (cond) { __builtin_amdgcn_s_sleep(8);   \
    if ((++_sp & 255u) == 0u) { if (xb_ld(&(bar)[XB_TMO])) break; if (_sp > XB_SPIN_CAP) { atomicAdd(&(bar)[XB_TMO], 1u); break; } } } } while (0)
struct XcdBarrier { unsigned* bar; unsigned x; volatile LAS unsigned* st; };
__device__ __forceinline__ XcdBarrier xcd_barrier_post(unsigned* bar, volatile LAS unsigned* st) {
    XcdBarrier b; b.bar = bar; b.x = xb_xcc_id(); b.st = st;
    if (threadIdx.x == 0) (void)xb_add(&bar[XB_XCNT(b.x)], 1u);
    return b;
}
__device__ __forceinline__ void xcd_barrier_complete(unsigned* bar, unsigned x, unsigned& nloc, unsigned& nx) {
    const unsigned G = gridDim.x * gridDim.y * gridDim.z;
    unsigned sum, cnt, mine, sp = 0u;
    for (;;) {
        sum = 0u; cnt = 0u; mine = 0u;
#pragma unroll
        for (unsigned j = 0; j < 16; ++j) { const unsigned c = xb_ld(&bar[XB_XCNT(j)]); sum += c; cnt += (c > 0u) ? 1u : 0u; mine = (j == x) ? c : mine; }
        if (sum == G) break;
        __builtin_amdgcn_s_sleep(1);
        if ((++sp & 255u) == 0u) { if (xb_ld(&bar[XB_TMO])) break; if (sp > XB_SPIN_CAP) { atomicAdd(&bar[XB_TMO], 1u); break; } }
    }
    nloc = mine > 0u ? mine : 1u; nx = cnt > 0u ? cnt : 1u;
}
__device__ __forceinline__ void xcd_barrier(const XcdBarrier& b) {
    asm volatile("s_waitcnt vmcnt(0)" ::: "memory");
    __syncthreads();
    if (threadIdx.x == 0) {
        unsigned* bar = b.bar;
        __builtin_amdgcn_s_waitcnt(0);
        unsigned nloc = b.st[0], nx = b.st[1];
        if (nloc == 0u) { xcd_barrier_complete(bar, b.x, nloc, nx); b.st[0] = nloc; b.st[1] = nx; }
        const unsigned old = xb_add(&bar[XB_XSUB(b.x)], 1u);
        const unsigned gen = old / nloc;
        if (old + 1u == (gen + 1u) * nloc) {
            __builtin_amdgcn_fence(__ATOMIC_RELEASE, "agent");
            asm volatile("s_waitcnt vmcnt(0)" ::: "memory");
            const unsigned og = xb_add(&bar[XB_TOP], 1u);
            const unsigned tg = og / nx;
            if (og + 1u == (tg + 1u) * nx) xb_add(&bar[XB_TOPGEN], 1u);
            else XB_SPIN(xb_ld(&bar[XB_TOPGEN]) == tg, bar);
            __builtin_amdgcn_fence(__ATOMIC_ACQUIRE, "agent");
            xb_add(&bar[XB_XGEN(b.x)], 1u);
            asm volatile("s_waitcnt vmcnt(0)" ::: "memory");
        } else {
            XB_SPIN(xb_ld(&bar[XB_XGEN(b.x)]) == gen, bar);
            __builtin_amdgcn_fence(__ATOMIC_ACQUIRE, "agent");
            asm volatile("s_waitcnt vmcnt(0)" ::: "memory");
        }
    }
    __syncthreads();
}

__global__ __launch_bounds__(512) void mega(Params p) {
    extern __shared__ __attribute__((aligned(16))) unsigned char shm[];
    LAS unsigned char* lds = (LAS unsigned char*)shm;
    cg::grid_group grid = cg::this_grid();
    unsigned char* ws = p.ws;
    bf16_t* xn = (bf16_t*)(ws + WS_XN);
    bf16_t* proj = (bf16_t*)(ws + WS_PROJ);
    bf16_t* act = proj;
    float* dbuf = (float*)(ws + WS_D);
    pg8::StaticOrder S;
    volatile LAS unsigned* xst = (volatile LAS unsigned*)(lds + 148992);
    if (threadIdx.x == 0) { xst[0] = 0u; xst[1] = 0u; }
    __syncthreads();
    const XcdBarrier xb = xcd_barrier_post((unsigned*)(ws + WS_BAR), xst);
#ifndef PROBE_REP
#define PROBE_REP 0
#endif
    int nbar = 0;
    for (int it = p.ph_lo; it < p.ph_hi; ++it) {
        int ph = it;
        if (PROBE_REP > 0) ph = it <= PROBE_REP ? it : it - 1;
        if (gdim_l() == 256 && (ph == 3 || ph == 10 || ph == 13)) continue;
        if (it > p.ph_lo) {
            if (nbar == 0) grid.sync();
            else xcd_barrier(xb);
            ++nbar;
        }
        __syncthreads();
        if (ph == 0) {
            phase_prep(p, lds);
        } else if (ph == 1 || ph == 11) {
            pg8::Gemm g{ph == 1 ? xn : (const bf16_t*)(ws + WS_XN2), (const bf16_t*)(ws + (ph == 1 ? WS_UP1 : WS_UP2)), MTOT, NUP, DM, DM};
            S.init(MTOT, NUP, gdim_l(), bid_l());
            EpiUp E{act};
            pg8::gemm_phase(lds, g, S, E);
            if (ph == 1 && gdim_l() == 256 && bid_l() >= 172) { __syncthreads(); prep_dn1(p, lds, 84, bid_l() - 172); }
        } else if (ph == 2 || ph == 12 || ph == 9) {
            pg8::Gemm g;
            if (ph == 9) g = pg8::Gemm{xn, (const bf16_t*)(ws + WS_OUT), MP, DM, DM, DM};
            else g = pg8::Gemm{act, (const bf16_t*)(ws + (ph == 2 ? WS_DN1 : WS_DN2)), MP, DM, DFF, DFF};
            S.init(MP, DM, gdim_l(), bid_l());
            if (gdim_l() == 256) {
                EpiNorm E;
                E.res = ph == 2 ? p.in[0] : p.out + O_Y; E.y = p.out + O_Y;
                E.xn = ph == 2 ? xn : (bf16_t*)(ws + WS_XN2);
                E.wpost = ph == 2 ? p.in[7] : (ph == 9 ? p.in[12] : p.in[31]);
                E.wnext = ph == 2 ? p.in[11] : (ph == 9 ? p.in[30] : nullptr);
                E.scale = ph == 9 ? 1.0f : 0.5f;
                E.slots = (unsigned long long*)(ws + WS_SLOTS); E.tag = (unsigned)ph;
                pg8::gemm_phase(lds, g, S, E);
                __syncthreads();
                SEpiNorm Es;
                Es.res = ph == 2 ? p.in[1] - (size_t)MP * DM : p.out + O_Y; Es.y = E.y; Es.xn = E.xn; Es.wpost = E.wpost; Es.wnext = E.wnext; Es.scale = E.scale;
                Es.slots = (unsigned long long*)(ws + WS_SSLOTS); Es.tag = (unsigned)ph;
                sgemm_s(lds, g.A, g.lda, g.Bt, g.K, Es);
            } else {
                EpiF32 E{(bf16_t*)dbuf};
                pg8::gemm_phase(lds, g, S, E);
                __syncthreads();
                SEpiF32 Es{(bf16_t*)dbuf};
                sgemm_s(lds, g.A, g.lda, g.Bt, g.K, Es);
            }
        } else if (ph == 3) {
            norm_pass(p, true, p.in[7], 0.5f, p.in[11], gdim_l() == 256 ? MP : 0, xn);
        } else if (ph == 10) {
            norm_pass(p, false, p.in[12], 1.0f, p.in[30], gdim_l() == 256 ? MP : 0, (bf16_t*)(ws + WS_XN2));
        } else if (ph == 13) {
            norm_pass(p, false, p.in[31], 0.5f, nullptr, gdim_l() == 256 ? MP : 0, xn);
        } else if (ph == 4) {
            pg8::Gemm g{xn, (const bf16_t*)(ws + WS_IN), MTOT, NIN, DM, DM};
            S.init(MTOT, NIN, gdim_l(), bid_l());
            EpiIn E{proj, (float*)(ws + WS_DT), p.in[23]};
            pg8::gemm_phase(lds, g, S, E);
            if (gdim_l() == 256 && bid_l() >= 146) { __syncthreads(); prep_late(p, lds, 110, bid_l() - 146); }
        } else if (ph == 5) {
            phase_bc(p);
            const int G = gdim_l(), bid = bid_l();
            RgPre rpre;
            { const int f0 = bid < 1056 ? bid : 0; rg_prefetch(p, f0 >> 3, f0 & 7, rpre); }
            for (int it2 = bid; it2 < 1056; it2 += G) {
                const int nx = it2 + G < 1056 ? it2 + G : it2;
                lds_barrier();
                rg_item(p, lds, it2 >> 3, it2 & 7, rpre, nx >> 3, nx & 7);
            }
        } else if (ph == 6) {
            phase_m1(p, lds);
        } else if (ph == 7) {
            phase_m3(p);
        } else if (ph == 8) {
            S.init(MP, DM, gdim_l(), bid_l());
            {
                pg8::Gemm g{proj + 1024, (const bf16_t*)(ws + WS_PRG), MP, DM, 3072, LDP};
                EpiGateCat E{proj + 8192, proj + 9216, xn};
                pg8::gemm_phase(lds, g, S, E);
            }
            __syncthreads();
            { SEpiGate1 Es{proj + 8192, (bf16_t*)dbuf}; sgemm_s(lds, proj + 1024, LDP, (const bf16_t*)(ws + WS_PRG), DM, Es, 3072); }
            { SEpiGate2 Es{proj + 9216, (const bf16_t*)dbuf, xn}; sgemm_s(lds, proj + 2048, LDP, (const bf16_t*)(ws + WS_PRG) + 1024, 2048, Es, 3072); }
        }
    }
}

extern "C" void kernel_launch(void* const* d_in, const int* in_sizes, int n_in, void* d_out, int out_size, void* d_ws, size_t ws_size, hipStream_t stream) {
    static int grid_blocks = 0;
    if (!grid_blocks) {
        if (n_in != 35 || ws_size < WS_NEED) { fprintf(stderr, "kernel_launch: unexpected n_in %d / ws_size %zu (need %zu)\n", n_in, ws_size, (size_t)WS_NEED); grid_blocks = -1; return; }
        int dev = 0, cus = 0, per_cu = 0;
        hipGetDevice(&dev);
        hipDeviceGetAttribute(&cus, hipDeviceAttributeMultiprocessorCount, dev);
        if (hipFuncSetAttribute((const void*)mega, hipFuncAttributeMaxDynamicSharedMemorySize, LDS_BYTES) != hipSuccess) { fprintf(stderr, "kernel_launch: hipFuncSetAttribute failed\n"); grid_blocks = -1; return; }
        if (hipOccupancyMaxActiveBlocksPerMultiprocessor(&per_cu, (const void*)mega, 512, LDS_BYTES) != hipSuccess || per_cu < 1) { fprintf(stderr, "kernel_launch: occupancy query failed (%d)\n", per_cu); grid_blocks = -1; return; }
        grid_blocks = cus * per_cu;
    }
    if (grid_blocks < 0) return;
    Params p{};
    for (int i = 0; i < 35; ++i) p.in[i] = (const float*)d_in[i];
    p.out = (float*)d_out; p.ws = (unsigned char*)d_ws;
#if MULTI_LAUNCH
    for (int ph = 0; ph < NPH; ++ph) {
        p.ph_lo = ph; p.ph_hi = ph + 1;
        hipLaunchKernelGGL(mega, dim3(grid_blocks), dim3(512), LDS_BYTES, stream, p);
    }
#else
    p.ph_lo = 0; p.ph_hi = NPH + (PROBE_REP > 0 ? 1 : 0);
    if (hipMemsetAsync((char*)d_ws + WS_BAR, 0, 16384, stream) != hipSuccess) { fprintf(stderr, "kernel_launch: memset of the barrier word failed\n"); return; }
    void* args[] = {&p};
    hipError_t e = hipLaunchCooperativeKernel((const void*)mega, dim3(grid_blocks), dim3(512), args, LDS_BYTES, stream);
    if (e != hipSuccess) fprintf(stderr, "cooperative launch failed: %s (grid %d)\n", hipGetErrorString(e), grid_blocks);
#endif
}
```

```cpp
#include <hip/hip_runtime.h>
#include <hip/hip_cooperative_groups.h>
#include <cstdio>
namespace cg = cooperative_groups;

#ifndef MULTI_LAUNCH
#define MULTI_LAUNCH 0
#endif

#define LAS __attribute__((address_space(3)))
typedef unsigned short bf16_t;
typedef short bf16x8 __attribute__((ext_vector_type(8)));
typedef float f32x4 __attribute__((ext_vector_type(4)));
typedef unsigned u32x4 __attribute__((ext_vector_type(4)));
typedef unsigned u32x2 __attribute__((ext_vector_type(2)));

constexpr int MTOT = 16896, MP = 16384, MS = 512, DM = 1024, DFF = 2816, NUP = 5632, LDP = 10240, NIN = 10496;
constexpr int NPH = 14;
constexpr int LDS_BYTES = 149504;

constexpr size_t WS_UP1 = 0;
constexpr size_t WS_DN1 = WS_UP1 + (size_t)NUP * DM * 2;
constexpr size_t WS_UP2 = WS_DN1 + (size_t)DM * DFF * 2;
constexpr size_t WS_DN2 = WS_UP2 + (size_t)NUP * DM * 2;
constexpr size_t WS_IN = WS_DN2 + (size_t)DM * DFF * 2;
constexpr size_t WS_PRG = WS_IN + (size_t)NIN * DM * 2;
constexpr size_t WS_PSSD = WS_PRG + (size_t)DM * DM * 2;
constexpr size_t WS_OUT = WS_PSSD + (size_t)DM * 2048 * 2;
constexpr size_t WS_GA = WS_OUT + (size_t)DM * DM * 2;
constexpr size_t WS_GX = WS_GA + (size_t)8 * 128 * 128 * 2;
constexpr size_t WS_XN = WS_GX + (size_t)8 * 128 * 128 * 2;
constexpr size_t WS_D = WS_XN + (size_t)MTOT * DM * 2;
constexpr size_t WS_PROJ = WS_D + (size_t)MTOT * DM * 4;
constexpr size_t WS_DT = WS_PROJ + (size_t)MTOT * LDP * 2;
constexpr size_t WS_RGTOT = WS_DT + (size_t)MTOT * 32 * 4;
constexpr size_t WS_END = WS_RGTOT + (size_t)128 * 1024 * 8;
constexpr size_t BC_BATCH = (size_t)2048 * 2048 * 2;
constexpr size_t WS_BAR = WS_END + 2 * BC_BATCH;
constexpr size_t WS_SLOTS = WS_BAR + 16384;
constexpr size_t WS_SSLOTS = WS_SLOTS + (size_t)2 * MP * 4 * 8;
constexpr size_t WS_NEED = WS_SSLOTS + (size_t)2 * MS * 16 * 8;
constexpr size_t WS_XN2 = WS_PROJ + (size_t)200 * 1024 * 1024;
__device__ __forceinline__ bf16_t* bc_base(unsigned char* ws, int b) {
    return (bf16_t*)(ws + (b < 4 ? WS_XN + (size_t)b * BC_BATCH : (b < 6 ? WS_UP1 + (size_t)(b - 4) * BC_BATCH : WS_END + (size_t)(b - 6) * BC_BATCH)));
}

constexpr size_t O_Y = 0;
constexpr size_t O_PRGH = (size_t)MTOT * DM;
constexpr size_t O_PRGC = O_PRGH + 8 * 1024;
constexpr size_t O_PSSD = O_PRGC + 8 * 3 * 1024;
constexpr size_t O_PSSDC = O_PSSD + (size_t)8 * 32 * 64 * 128;
constexpr size_t O_SRGH = O_PSSDC + 8 * 3 * 4096;
constexpr size_t O_SRGC = O_SRGH + 128 * 1024;
constexpr size_t O_SSSD = O_SRGC + 128 * 3 * 1024;
constexpr size_t O_SSSDC = O_SSSD + (size_t)128 * 32 * 64 * 128;

struct Params {
    const float* in[35];
    float* out;
    unsigned char* ws;
    int ph_lo, ph_hi;
};

__device__ __forceinline__ unsigned pk_bf16(float lo, float hi) { unsigned r; asm volatile("v_cvt_pk_bf16_f32 %0, %1, %2" : "=v"(r) : "v"(lo), "v"(hi)); return r; }
__device__ __forceinline__ bf16_t f2bf(float f) { return (bf16_t)(pk_bf16(f, 0.f) & 0xffffu); }
__device__ __forceinline__ float bf2f(bf16_t h) { return __uint_as_float((unsigned)h << 16); }
__device__ __forceinline__ float bflo(unsigned u) { return __uint_as_float(u << 16); }
__device__ __forceinline__ float bfhi(unsigned u) { return __uint_as_float(u & 0xffff0000u); }
__device__ __forceinline__ float sigmoidf_(float x) { return __builtin_amdgcn_rcpf(1.f + __expf(-x)); }
__device__ __forceinline__ float siluf_(float x) { return x * sigmoidf_(x); }
__device__ __forceinline__ float geluf_(float v) { return v * sigmoidf_(1.5957691216057308f * (v + 0.044715f * v * v * v)); }
__device__ __forceinline__ float log1p_pos(float e) { return e < 0.06f ? e * (1.f + e * (-0.5f + e * (0.33333333f + e * -0.25f))) : __logf(1.f + e); }
__device__ __forceinline__ float softplusf_(float x) { return x > 20.f ? x : log1p_pos(__expf(x)); }
__device__ __forceinline__ float neg_expm1_neg(float x) {
    return x > -0.25f ? -x * (1.f + x * (0.5f + x * (0.16666667f + x * (0.041666668f + x * 0.0083333338f)))) : 1.f - __expf(x);
}
__device__ __forceinline__ void lds_barrier() { asm volatile("s_waitcnt lgkmcnt(0)" ::: "memory"); __builtin_amdgcn_s_barrier(); asm volatile("" ::: "memory"); }
__device__ __forceinline__ int bid_l() { int t = blockIdx.x; asm volatile("" : "+s"(t)); return t; }
__device__ __forceinline__ int gdim_l() { int t = gridDim.x; asm volatile("" : "+s"(t)); return t; }
__device__ __forceinline__ int tid_l() { int t = threadIdx.x; asm volatile("" : "+v"(t)); return t; }
__device__ __forceinline__ float bperm(float v, int srclane) { return __int_as_float(__builtin_amdgcn_ds_bpermute(srclane << 2, __float_as_int(v))); }
__device__ __forceinline__ float wave_sum(float v, int lane) {
#pragma unroll
    for (int o = 32; o; o >>= 1) v += bperm(v, lane ^ o);
    return v;
}
__device__ __forceinline__ void unpack8(u32x4 v, float* f) {
    f[0] = bflo(v[0]); f[1] = bfhi(v[0]); f[2] = bflo(v[1]); f[3] = bfhi(v[1]);
    f[4] = bflo(v[2]); f[5] = bfhi(v[2]); f[6] = bflo(v[3]); f[7] = bfhi(v[3]);
}
__device__ __forceinline__ u32x4 pack8(const float* f) {
    u32x4 o; o[0] = pk_bf16(f[0], f[1]); o[1] = pk_bf16(f[2], f[3]); o[2] = pk_bf16(f[4], f[5]); o[3] = pk_bf16(f[6], f[7]); return o;
}

namespace pg8 {
constexpr int BM = 256, BK = 64, HALF = 128, HTB = HALF * BK * 2, STAGE_BYTES = 8 * HTB, NXCD = 8, WGM = 8;
__device__ __forceinline__ int lds_byte(int r, int c) { const int st = (r >> 4) * 2 + (c >> 5), rr = r & 15, cc = c & 31, ob = rr * 64 + cc * 2; return st * 1024 + (ob ^ (((ob >> 9) & 1) << 5)); }
__device__ __forceinline__ void stage_rc(int b, int& R, int& C) { const int st = b / 1024, sb = b % 1024, swz = sb ^ (((sb >> 9) & 1) << 5); R = (st >> 1) * 16 + swz / 64; C = (st & 1) * 32 + (swz % 64) / 2; }
__device__ __forceinline__ int perm32(int rho) { const int n = rho >> 4, i = rho & 15; return 8 * (i >> 2) + 4 * n + (i & 3); }
struct Unit { int pm, pn; };
struct Gemm { const bf16_t* A; const bf16_t* Bt; int M, N, K, lda; };
struct StaticOrder {
    int nM, nN, nwg, G, c;
    __device__ void init(int M, int N, int G_, int c_) { nM = M / BM; nN = N / BM; nwg = nM * nN; G = G_; c = c_; }
    __device__ bool next(int i, Unit& u) const {
        const long L = (long)i * G + c; if (L >= nwg) return false;
        int wgid = (int)L; { const int q = nwg / NXCD, r = nwg % NXCD, xcd = wgid % NXCD, off = wgid / NXCD; wgid = (xcd < r ? xcd * (q + 1) : r * (q + 1) + (xcd - r) * q) + off; }
        const int nig = WGM * nN, gid = wgid / nig, fm = gid * WGM, gsz = (nM - fm) < WGM ? (nM - fm) : WGM;
        u.pm = fm + ((wgid % nig) % gsz); u.pn = (wgid % nig) / gsz; return true;
    }
};

template <class E> constexpr int mid_tile = 0;
template <class Epi>
__device__ __forceinline__ void gemm_phase(LAS unsigned char* lds, const Gemm g, const StaticOrder& S, const Epi& E) {
    const int tid = tid_l(), wid = __builtin_amdgcn_readfirstlane(tid >> 6), lane = tid & 63, wr = wid >> 2, wc = wid & 3, fr = lane & 15, fq = lane >> 4;
    const int K = g.K, nt = K / BK, lda = g.lda;
    unsigned voffA[2], voffB[2];
#pragma unroll
    for (int i = 0; i < 2; ++i) { int R, C; stage_rc(tid * 16 + i * 8192, R, C); const int Rb = (R & ~31) + perm32(R & 31);
        voffA[i] = (unsigned)(R * lda + C) * 2u; voffB[i] = (unsigned)(Rb * K + C) * 2u; }
    const size_t kstep = (size_t)(BK * 2);
    const size_t hstepA = (size_t)HALF * lda * 2, hstepB = (size_t)HALF * K * 2;
    const size_t tstepA = 2 * hstepA, tstepB = 2 * hstepB;
    const unsigned ldsw = (unsigned)wid * 1024u;
    const int aoff = lds_byte(wr * 64 + fr, fq * 8), boff = lds_byte(wc * 32 + fr, fq * 8);
#define PG8_SA(b, h) (((b) * 2 + (h)) * HTB)
#define PG8_SB(b, h) ((4 + (b) * 2 + (h)) * HTB)
#define PG8_STAGE(bufoff, gbase, voff) do { _Pragma("unroll") for (int _i = 0; _i < 2; ++_i) \
        __builtin_amdgcn_global_load_lds((const unsigned*)((const char*)(gbase) + (voff)[_i]), (LAS unsigned*)(lds + (bufoff) + ldsw + _i * 8192), 16, 0, 0); } while (0)
#define PG8_LDA(dst, b, h) do { _Pragma("unroll") for (int m = 0; m < 4; ++m) _Pragma("unroll") for (int k = 0; k < 2; ++k) dst[m][k] = *(const LAS bf16x8*)(lds + PG8_SA(b, h) + aoff + m * 2048 + k * 1024); } while (0)
#define PG8_LDB(dst, b, h) do { _Pragma("unroll") for (int n = 0; n < 2; ++n) _Pragma("unroll") for (int k = 0; k < 2; ++k) dst[n][k] = *(const LAS bf16x8*)(lds + PG8_SB(b, h) + boff + n * 2048 + k * 1024); } while (0)
#define PG8_MMA(ai, bj, At, Bt) do { __builtin_amdgcn_s_setprio(1); _Pragma("unroll") for (int m = 0; m < 4; ++m) _Pragma("unroll") for (int n = 0; n < 2; ++n) _Pragma("unroll") for (int k = 0; k < 2; ++k) \
        acc[ai][bj][m][n] = __builtin_amdgcn_mfma_f32_16x16x32_bf16(Bt[n][k], At[m][k], acc[ai][bj][m][n], 0, 0, 0); __builtin_amdgcn_s_setprio(0); } while (0)
#define PG8_WAIT_V(n) asm volatile("s_waitcnt vmcnt(" #n ")" ::: "memory")
#define PG8_WAIT_L(n) asm volatile("s_waitcnt lgkmcnt(" #n ")" ::: "memory")
#define PG8_BAR __builtin_amdgcn_s_barrier()
#define PG8_SCHED __builtin_amdgcn_sched_barrier(0)
    Unit cur, nxt; int ui = 0;
    if (!S.next(0, cur)) return;
    f32x4 acc[2][2][4][2];
#pragma unroll
    for (int a = 0; a < 2; ++a)
#pragma unroll
        for (int b = 0; b < 2; ++b)
#pragma unroll
            for (int m = 0; m < 4; ++m)
#pragma unroll
                for (int n = 0; n < 2; ++n) acc[a][b][m][n] = (f32x4){0.f, 0.f, 0.f, 0.f};
    bf16x8 At[4][2], B0[2][2], B1[2][2];
    const char* cA = (const char*)g.A + (size_t)cur.pm * tstepA; const char* cB = (const char*)g.Bt + (size_t)cur.pn * tstepB;
    PG8_STAGE(PG8_SB(0, 0), cB, voffB); PG8_STAGE(PG8_SA(0, 0), cA, voffA); PG8_STAGE(PG8_SB(0, 1), cB + hstepB, voffB); PG8_STAGE(PG8_SA(0, 1), cA + hstepA, voffA);
    if (wr == 1) PG8_BAR;
    PG8_WAIT_V(4); PG8_BAR;
    PG8_STAGE(PG8_SB(1, 0), cB + kstep, voffB); PG8_STAGE(PG8_SA(1, 0), cA + kstep, voffA); PG8_STAGE(PG8_SB(1, 1), cB + hstepB + kstep, voffB);
    PG8_WAIT_V(6); PG8_BAR;
    for (;;) {
        const bool has_next = S.next(ui + 1, nxt);
        const char* nA = has_next ? (const char*)g.A + (size_t)nxt.pm * tstepA : cA; const char* nB = has_next ? (const char*)g.Bt + (size_t)nxt.pn * tstepB : cB;
        for (int t = 0; t < nt; t += 2) {
            if constexpr (mid_tile<Epi> != 0) { if (t == mid_tile<Epi>) E.mid(acc, cur, wr, wc, fr, fq); }
            const bool last = (t == nt - 2);
            const char* a1 = cA + (size_t)(t + 1) * kstep;
            const char* a2 = last ? nA : cA + (size_t)(t + 2) * kstep; const char* b2 = last ? nB : cB + (size_t)(t + 2) * kstep;
            const char* a3 = a2 + kstep; const char* b3 = b2 + kstep;
            PG8_LDB(B0, 0, 0); PG8_SCHED; PG8_LDA(At, 0, 0); PG8_STAGE(PG8_SA(1, 1), a1 + hstepA, voffA);
            PG8_WAIT_L(8); PG8_BAR; PG8_WAIT_L(0); PG8_MMA(0, 0, At, B0); PG8_BAR; PG8_SCHED;
            PG8_LDB(B1, 0, 1); PG8_STAGE(PG8_SB(0, 0), b2, voffB);
            PG8_BAR; PG8_WAIT_L(0); PG8_MMA(0, 1, At, B1); PG8_BAR;
            PG8_LDA(At, 0, 1); PG8_STAGE(PG8_SA(0, 0), a2, voffA);
            PG8_BAR; PG8_WAIT_L(0); PG8_MMA(1, 0, At, B0); PG8_BAR; PG8_SCHED;
            PG8_STAGE(PG8_SB(0, 1), b2 + hstepB, voffB);
            PG8_WAIT_V(6); PG8_BAR; PG8_MMA(1, 1, At, B1); PG8_BAR;
            PG8_LDB(B0, 1, 0); PG8_SCHED; PG8_LDA(At, 1, 0); PG8_STAGE(PG8_SA(0, 1), a2 + hstepA, voffA);
            PG8_WAIT_L(8); PG8_BAR; PG8_WAIT_L(0); PG8_MMA(0, 0, At, B0); PG8_BAR; PG8_SCHED;
            PG8_LDB(B1, 1, 1); PG8_STAGE(PG8_SB(1, 0), b3, voffB);
            PG8_BAR; PG8_WAIT_L(0); PG8_MMA(0, 1, At, B1); PG8_BAR;
            PG8_LDA(At, 1, 1); PG8_STAGE(PG8_SA(1, 0), a3, voffA);
            PG8_BAR; PG8_WAIT_L(0); PG8_MMA(1, 0, At, B0); PG8_BAR; PG8_SCHED;
            PG8_STAGE(PG8_SB(1, 1), b3 + hstepB, voffB);
            PG8_WAIT_V(6); PG8_BAR; PG8_MMA(1, 1, At, B1); PG8_BAR;
        }
        if constexpr (!Epi::FUSED) E(acc, cur, wr, wc, fr, fq);
        if (!has_next) break;
#pragma unroll
        for (int a = 0; a < 2; ++a)
#pragma unroll
            for (int b = 0; b < 2; ++b)
#pragma unroll
                for (int m = 0; m < 4; ++m)
#pragma unroll
                    for (int n = 0; n < 2; ++n) acc[a][b][m][n] = (f32x4){0.f, 0.f, 0.f, 0.f};
        cur = nxt; cA = nA; cB = nB; ++ui;
    }
    PG8_WAIT_V(0);
    if (wr == 0) PG8_BAR;
    PG8_BAR;
    if constexpr (Epi::FUSED) E.fused(acc, cur, wr, wc, fr, fq, lds, tid, lane);
#undef PG8_SA
#undef PG8_SB
#undef PG8_STAGE
#undef PG8_LDA
#undef PG8_LDB
#undef PG8_MMA
#undef PG8_WAIT_V
#undef PG8_WAIT_L
#undef PG8_BAR
#undef PG8_SCHED
}
}

struct EpiUp {
    static constexpr bool FUSED = false;
    bf16_t* act;
    __device__ __forceinline__ void operator()(const f32x4 (&acc)[2][2][4][2], const pg8::Unit& u, int wr, int wc, int fr, int fq) const {
        const int row0 = u.pm * 256 + wr * 64 + fr, col0 = u.pn * 128 + wc * 32 + 8 * fq;
#pragma unroll
        for (int ai = 0; ai < 2; ++ai)
#pragma unroll
            for (int m = 0; m < 4; ++m) {
                const f32x4 g0 = acc[ai][0][m][0], g1 = acc[ai][0][m][1], u0 = acc[ai][1][m][0], u1 = acc[ai][1][m][1];
                u32x4 o;
                o[0] = pk_bf16(siluf_(g0[0]) * u0[0], siluf_(g0[1]) * u0[1]); o[1] = pk_bf16(siluf_(g0[2]) * u0[2], siluf_(g0[3]) * u0[3]);
                o[2] = pk_bf16(siluf_(g1[0]) * u1[0], siluf_(g1[1]) * u1[1]); o[3] = pk_bf16(siluf_(g1[2]) * u1[2], siluf_(g1[3]) * u1[3]);
                *(u32x4*)(act + (size_t)(row0 + ai * 128 + m * 16) * DFF + col0) = o;
            }
    }
};
struct EpiF32 {
    static constexpr bool FUSED = false;
    bf16_t* C;
    __device__ __forceinline__ void operator()(const f32x4 (&acc)[2][2][4][2], const pg8::Unit& u, int wr, int wc, int fr, int fq) const {
        const int row0 = u.pm * 256 + wr * 64 + fr, col0 = u.pn * 256 + wc * 32 + 8 * fq;
#pragma unroll
        for (int ai = 0; ai < 2; ++ai)
#pragma unroll
            for (int m = 0; m < 4; ++m) {
                bf16_t* rowp = C + (size_t)(row0 + ai * 128 + m * 16) * DM + col0;
#pragma unroll
                for (int bj = 0; bj < 2; ++bj) {
                    const f32x4 v0 = acc[ai][bj][m][0], v1 = acc[ai][bj][m][1];
                    u32x4 o; o[0] = pk_bf16(v0[0], v0[1]); o[1] = pk_bf16(v0[2], v0[3]); o[2] = pk_bf16(v1[0], v1[1]); o[3] = pk_bf16(v1[2], v1[3]);
                    *(u32x4*)(rowp + bj * 128) = o;
                }
            }
    }
};
struct EpiIn {
    static constexpr bool FUSED = false;
    bf16_t* proj; float* dt; const float* dt_bias;
    __device__ __forceinline__ void operator()(const f32x4 (&acc)[2][2][4][2], const pg8::Unit& u, int wr, int wc, int fr, int fq) const {
        const int row0 = u.pm * 256 + wr * 64 + fr;
        if (u.pn < 40) {
            const int col0 = u.pn * 256 + wc * 32 + 8 * fq;
#pragma unroll
            for (int ai = 0; ai < 2; ++ai)
#pragma unroll
                for (int m = 0; m < 4; ++m) {
                    bf16_t* rowp = proj + (size_t)(row0 + ai * 128 + m * 16) * LDP + col0;
#pragma unroll
                    for (int bj = 0; bj < 2; ++bj) {
                        const f32x4 v0 = acc[ai][bj][m][0], v1 = acc[ai][bj][m][1];
                        u32x4 o; o[0] = pk_bf16(v0[0], v0[1]); o[1] = pk_bf16(v0[2], v0[3]); o[2] = pk_bf16(v1[0], v1[1]); o[3] = pk_bf16(v1[2], v1[3]);
                        __builtin_nontemporal_store(o, (u32x4*)(rowp + bj * 128));
                    }
                }
        } else if (wc == 0) {
            const int lc = 8 * fq;
            const f32x4 b0 = *(const f32x4*)(dt_bias + lc), b1 = *(const f32x4*)(dt_bias + lc + 4);
#pragma unroll
            for (int ai = 0; ai < 2; ++ai)
#pragma unroll
                for (int m = 0; m < 4; ++m) {
                    float* rowp = dt + (size_t)(row0 + ai * 128 + m * 16) * 32 + lc;
                    const f32x4 v0 = acc[ai][0][m][0] + b0, v1 = acc[ai][0][m][1] + b1;
                    f32x4 o0, o1;
#pragma unroll
                    for (int j = 0; j < 4; ++j) { o0[j] = softplusf_(v0[j]); o1[j] = softplusf_(v1[j]); }
                    *(f32x4*)rowp = o0; *(f32x4*)(rowp + 4) = o1;
                }
        }
    }
};
struct EpiGate1 {
    static constexpr bool FUSED = false;
    const bf16_t* gate; bf16_t* t;
    __device__ __forceinline__ void operator()(const f32x4 (&acc)[2][2][4][2], const pg8::Unit& u, int wr, int wc, int fr, int fq) const {
        const int row0 = u.pm * 256 + wr * 64 + fr, col0 = u.pn * 256 + wc * 32 + 8 * fq;
#pragma unroll
        for (int ai = 0; ai < 2; ++ai)
#pragma unroll
            for (int m = 0; m < 4; ++m) {
                const size_t r = (size_t)(row0 + ai * 128 + m * 16);
#pragma unroll
                for (int bj = 0; bj < 2; ++bj) {
                    float gf[8]; unpack8(*(const u32x4*)(gate + r * LDP + col0 + bj * 128), gf);
                    const f32x4 v0 = acc[ai][bj][m][0], v1 = acc[ai][bj][m][1];
                    float o[8];
#pragma unroll
                    for (int j = 0; j < 4; ++j) { o[j] = sigmoidf_(gf[j]) * v0[j]; o[4 + j] = sigmoidf_(gf[4 + j]) * v1[j]; }
                    *(u32x4*)(t + r * DM + col0 + bj * 128) = pack8(o);
                }
            }
    }
};
struct EpiGate2 {
    static constexpr bool FUSED = false;
    const bf16_t* gate; const bf16_t* t; bf16_t* mo;
    __device__ __forceinline__ void operator()(const f32x4 (&acc)[2][2][4][2], const pg8::Unit& u, int wr, int wc, int fr, int fq) const {
        const int row0 = u.pm * 256 + wr * 64 + fr, col0 = u.pn * 256 + wc * 32 + 8 * fq;
#pragma unroll
        for (int ai = 0; ai < 2; ++ai)
#pragma unroll
            for (int m = 0; m < 4; ++m) {
                const size_t r = (size_t)(row0 + ai * 128 + m * 16);
#pragma unroll
                for (int bj = 0; bj < 2; ++bj) {
                    float gf[8]; unpack8(*(const u32x4*)(gate + r * LDP + col0 + bj * 128), gf);
                    float tf[8]; unpack8(*(const u32x4*)(t + r * DM + col0 + bj * 128), tf);
                    const f32x4 v0 = acc[ai][bj][m][0], v1 = acc[ai][bj][m][1];
                    float o[8];
#pragma unroll
                    for (int j = 0; j < 4; ++j) { o[j] = tf[j] + sigmoidf_(gf[j]) * v0[j]; o[4 + j] = tf[4 + j] + sigmoidf_(gf[4 + j]) * v1[j]; }
                    *(u32x4*)(mo + r * DM + col0 + bj * 128) = pack8(o);
                }
            }
    }
};


struct EpiGateCat {
    static constexpr bool FUSED = false;
    const bf16_t* grg; const bf16_t* gssd; bf16_t* mo;
    __device__ __forceinline__ void mid(f32x4 (&acc)[2][2][4][2], const pg8::Unit& u, int wr, int wc, int fr, int fq) const {
        const int rbase = (u.pm * 256 + wr * 64 + fr) * LDP + u.pn * 256 + wc * 32 + 8 * fq;
#pragma unroll
        for (int ai = 0; ai < 2; ++ai)
#pragma unroll
            for (int m = 0; m < 4; ++m) {
                int off = rbase + (ai * 128 + m * 16) * LDP; asm volatile("" : "+v"(off));
#pragma unroll
                for (int bj = 0; bj < 2; ++bj) {
                    float ga[8], gb[8];
                    unpack8(*(const u32x4*)(grg + off + bj * 128), ga);
                    unpack8(*(const u32x4*)(gssd + off + bj * 128), gb);
#pragma unroll
                    for (int j = 0; j < 4; ++j) {
                        acc[ai][bj][m][0][j] *= sigmoidf_(ga[j]) * (1.f + __expf(-gb[j]));
                        acc[ai][bj][m][1][j] *= sigmoidf_(ga[4 + j]) * (1.f + __expf(-gb[4 + j]));
                    }
                }
                __builtin_amdgcn_sched_barrier(0);
            }
        asm volatile("s_waitcnt vmcnt(0)" ::: "memory");
    }
    __device__ __forceinline__ void operator()(const f32x4 (&acc)[2][2][4][2], const pg8::Unit& u, int wr, int wc, int fr, int fq) const {
        const int row0 = u.pm * 256 + wr * 64 + fr, col0 = u.pn * 256 + wc * 32 + 8 * fq;
#pragma unroll
        for (int ai = 0; ai < 2; ++ai)
#pragma unroll
            for (int m = 0; m < 4; ++m) {
                const size_t r = (size_t)(row0 + ai * 128 + m * 16);
#pragma unroll
                for (int bj = 0; bj < 2; ++bj) {
                    float gb[8]; unpack8(*(const u32x4*)(gssd + r * LDP + col0 + bj * 128), gb);
                    const f32x4 v0 = acc[ai][bj][m][0], v1 = acc[ai][bj][m][1];
                    float o[8];
#pragma unroll
                    for (int j = 0; j < 4; ++j) { o[j] = sigmoidf_(gb[j]) * v0[j]; o[4 + j] = sigmoidf_(gb[4 + j]) * v1[j]; }
                    *(u32x4*)(mo + r * DM + col0 + bj * 128) = pack8(o);
                }
            }
    }
};
template <> constexpr int pg8::mid_tile<EpiGateCat> = 16;

struct EpiNorm {
    static constexpr bool FUSED = true;
    const float* res; float* y; bf16_t* xn; const float* wpost; const float* wnext; float scale;
    unsigned long long* slots; unsigned tag;
    __device__ __forceinline__ void row_exchange(const float (&s)[2][4], float (&tot)[2][4], int ex, const pg8::Unit& u, int wr, int wc, int fr, int fq, LAS unsigned char* lds, int tid, int lane) const {
        LAS float* part = (LAS float*)lds; LAS float* rowsum = part + 1024;
        __syncthreads();
#pragma unroll
        for (int ai = 0; ai < 2; ++ai)
#pragma unroll
            for (int m = 0; m < 4; ++m) {
                float v = s[ai][m];
                v += bperm(v, lane ^ 16); v += bperm(v, lane ^ 32);
                if (fq == 0) part[(ai * 128 + wr * 64 + m * 16 + fr) * 4 + wc] = v;
            }
        __syncthreads();
        if (tid < 256) {
            const float mine = part[tid * 4] + part[tid * 4 + 1] + part[tid * 4 + 2] + part[tid * 4 + 3];
            unsigned long long* sl = slots + ((size_t)ex * MP + (size_t)u.pm * 256 + tid) * 4;
            __hip_atomic_store(sl + u.pn, ((unsigned long long)tag << 32) | (unsigned long long)__float_as_uint(mine), __ATOMIC_RELAXED, __HIP_MEMORY_SCOPE_AGENT);
            float total = mine;
            for (int q = 0; q < 4; ++q) {
                if (q == u.pn) continue;
                unsigned long long g;
                while ((unsigned)((g = __hip_atomic_load(sl + q, __ATOMIC_RELAXED, __HIP_MEMORY_SCOPE_AGENT)) >> 32) != tag) __builtin_amdgcn_s_sleep(2);
                total += __uint_as_float((unsigned)g);
            }
            rowsum[tid] = total;
        }
        __syncthreads();
#pragma unroll
        for (int ai = 0; ai < 2; ++ai)
#pragma unroll
            for (int m = 0; m < 4; ++m) tot[ai][m] = rowsum[ai * 128 + wr * 64 + m * 16 + fr];
    }
    __device__ __forceinline__ void fused(f32x4 (&acc)[2][2][4][2], const pg8::Unit& u, int wr, int wc, int fr, int fq, LAS unsigned char* lds, int tid, int lane) const {
        const int row0 = u.pm * 256 + wr * 64 + fr, col0 = u.pn * 256 + wc * 32 + 8 * fq;
        float s[2][4], tot[2][4];
#pragma unroll
        for (int ai = 0; ai < 2; ++ai)
#pragma unroll
            for (int m = 0; m < 4; ++m) {
                float v = 0.f;
#pragma unroll
                for (int bj = 0; bj < 2; ++bj)
#pragma unroll
                    for (int n = 0; n < 2; ++n)
#pragma unroll
                        for (int j = 0; j < 4; ++j) v += acc[ai][bj][m][n][j] * acc[ai][bj][m][n][j];
                s[ai][m] = v;
            }
        row_exchange(s, tot, 0, u, wr, wc, fr, fq, lds, tid, lane);
        f32x4 wp[2][2];
#pragma unroll
        for (int bj = 0; bj < 2; ++bj) { wp[bj][0] = *(const f32x4*)(wpost + col0 + bj * 128); wp[bj][1] = *(const f32x4*)(wpost + col0 + bj * 128 + 4); }
#pragma unroll
        for (int ai = 0; ai < 2; ++ai)
#pragma unroll
            for (int m = 0; m < 4; ++m) {
                const float r = rsqrtf(tot[ai][m] * (1.f / DM) + 1e-6f) * scale;
                const size_t ro = (size_t)(row0 + ai * 128 + m * 16) * DM + col0;
                float v2 = 0.f;
#pragma unroll
                for (int bj = 0; bj < 2; ++bj)
#pragma unroll
                    for (int n = 0; n < 2; ++n) {
                        const f32x4 xr = *(const f32x4*)(res + ro + bj * 128 + n * 4);
                        f32x4 o = xr + acc[ai][bj][m][n] * r * wp[bj][n];
                        acc[ai][bj][m][n] = o;
                        __builtin_nontemporal_store(o, (f32x4*)(y + ro + bj * 128 + n * 4));
                        v2 += o[0] * o[0] + o[1] * o[1] + o[2] * o[2] + o[3] * o[3];
                    }
                s[ai][m] = v2;
            }
        if (wnext) {
            row_exchange(s, tot, 1, u, wr, wc, fr, fq, lds, tid, lane);
#pragma unroll
            for (int bj = 0; bj < 2; ++bj) { wp[bj][0] = *(const f32x4*)(wnext + col0 + bj * 128); wp[bj][1] = *(const f32x4*)(wnext + col0 + bj * 128 + 4); }
#pragma unroll
            for (int ai = 0; ai < 2; ++ai)
#pragma unroll
                for (int m = 0; m < 4; ++m) {
                    const float r2 = rsqrtf(tot[ai][m] * (1.f / DM) + 1e-6f);
                    const size_t ro = (size_t)(row0 + ai * 128 + m * 16) * DM + col0;
#pragma unroll
                    for (int bj = 0; bj < 2; ++bj) {
                        const f32x4 a0 = acc[ai][bj][m][0] * r2 * wp[bj][0], a1 = acc[ai][bj][m][1] * r2 * wp[bj][1];
                        u32x4 o; o[0] = pk_bf16(a0[0], a0[1]); o[1] = pk_bf16(a0[2], a0[3]); o[2] = pk_bf16(a1[0], a1[1]); o[3] = pk_bf16(a1[2], a1[3]);
                        *(u32x4*)(xn + ro + bj * 128) = o;
                    }
                }
        }
    }
};

struct SEpiF32 { static constexpr bool NORM = false; bf16_t* C; __device__ __forceinline__ void operator()(int row, int col, f32x4 s) const { u32x2 o; o[0] = pk_bf16(s[0], s[1]); o[1] = pk_bf16(s[2], s[3]); *(u32x2*)(C + (size_t)row * DM + col) = o; } };
struct SEpiGate1 { static constexpr bool NORM = false; const bf16_t* gate; bf16_t* t;
    __device__ __forceinline__ void operator()(int row, int col, f32x4 s) const {
        const u32x2 gv = *(const u32x2*)(gate + (size_t)row * LDP + col);
        u32x2 o; o[0] = pk_bf16(sigmoidf_(bflo(gv[0])) * s[0], sigmoidf_(bfhi(gv[0])) * s[1]); o[1] = pk_bf16(sigmoidf_(bflo(gv[1])) * s[2], sigmoidf_(bfhi(gv[1])) * s[3]);
        *(u32x2*)(t + (size_t)row * DM + col) = o; } };
struct SEpiGate2 { static constexpr bool NORM = false; const bf16_t* gate; const bf16_t* t; bf16_t* mo;
    __device__ __forceinline__ void operator()(int row, int col, f32x4 s) const {
        const u32x2 gv = *(const u32x2*)(gate + (size_t)row * LDP + col);
        const u32x2 tr = *(const u32x2*)(t + (size_t)row * DM + col);
        const f32x4 tv = {bflo(tr[0]), bfhi(tr[0]), bflo(tr[1]), bfhi(tr[1])};
        u32x2 o; o[0] = pk_bf16(tv[0] + sigmoidf_(bflo(gv[0])) * s[0], tv[1] + sigmoidf_(bfhi(gv[0])) * s[1]);
        o[1] = pk_bf16(tv[2] + sigmoidf_(bflo(gv[1])) * s[2], tv[3] + sigmoidf_(bfhi(gv[1])) * s[3]);
        *(u32x2*)(mo + (size_t)row * DM + col) = o; } };
struct SEpiNorm {
    static constexpr bool NORM = true;
    const float* res; float* y; bf16_t* xn; const float* wpost; const float* wnext; float scale;
    unsigned long long* slots; unsigned tag;
    __device__ __forceinline__ float row_total(float v, int ex, int row, int tc, int lane) const {
        v += bperm(v, lane ^ 1); v += bperm(v, lane ^ 2); v += bperm(v, lane ^ 4); v += bperm(v, lane ^ 8);
        unsigned long long* sl = slots + ((size_t)ex * MS + (size_t)(row - MP)) * 16;
        const int q = lane & 15;
        if (q == 0) __hip_atomic_store(sl + tc, ((unsigned long long)tag << 32) | (unsigned long long)__float_as_uint(v), __ATOMIC_RELAXED, __HIP_MEMORY_SCOPE_AGENT);
        float part = v;
        if (q != tc) {
            unsigned long long g;
            while ((unsigned)((g = __hip_atomic_load(sl + q, __ATOMIC_RELAXED, __HIP_MEMORY_SCOPE_AGENT)) >> 32) != tag) __builtin_amdgcn_s_sleep(2);
            part = __uint_as_float((unsigned)g);
        }
        part += bperm(part, lane ^ 1); part += bperm(part, lane ^ 2); part += bperm(part, lane ^ 4); part += bperm(part, lane ^ 8);
        return part;
    }
    __device__ __forceinline__ void operator()(int row, int col, f32x4 s, int tc, int lane) const {
        const float tot = row_total(s[0] * s[0] + s[1] * s[1] + s[2] * s[2] + s[3] * s[3], 0, row, tc, lane);
        const float r = rsqrtf(tot * (1.f / DM) + 1e-6f) * scale;
        const f32x4 xr = *(const f32x4*)(res + (size_t)row * DM + col), wp = *(const f32x4*)(wpost + col);
        const f32x4 o = xr + s * r * wp;
        *(f32x4*)(y + (size_t)row * DM + col) = o;
        if (wnext) {
            const float tot2 = row_total(o[0] * o[0] + o[1] * o[1] + o[2] * o[2] + o[3] * o[3], 1, row, tc, lane);
            const float r2 = rsqrtf(tot2 * (1.f / DM) + 1e-6f);
            const f32x4 wn = *(const f32x4*)(wnext + col);
            u32x2 ob; ob[0] = pk_bf16(o[0] * r2 * wn[0], o[1] * r2 * wn[1]); ob[1] = pk_bf16(o[2] * r2 * wn[2], o[3] * r2 * wn[3]);
            *(u32x2*)(xn + (size_t)row * DM + col) = ob;
        }
    }
};
template <class Epi>
__device__ __forceinline__ void sgemm_s(LAS unsigned char* lds, const bf16_t* A, int lda, const bf16_t* Bt, int K, const Epi& E, int ldb = 0) {
    const int tid = tid_l(), lane = tid & 63, w = __builtin_amdgcn_readfirstlane(tid >> 6), fr = lane & 15, fq = lane >> 4;
    const int G = gdim_l(), bid = bid_l();
    LAS float* red = (LAS float*)lds;
    const int kw = K >> 3, nks = kw >> 5;
    for (int tile = bid; tile < 256; tile += G) {
        const int row0 = MP + (tile >> 4) * 32, col0 = (tile & 15) * 64;
        f32x4 acc[2][4];
#pragma unroll
        for (int mt = 0; mt < 2; ++mt)
#pragma unroll
            for (int nt = 0; nt < 4; ++nt) acc[mt][nt] = (f32x4){0.f, 0.f, 0.f, 0.f};
        const bf16_t* ap = A + (size_t)(row0 + fr) * lda + w * kw + fq * 8;
        const int ldbe = ldb ? ldb : K;
        const bf16_t* bp = Bt + (size_t)(col0 + fr) * ldbe + w * kw + fq * 8;
        for (int ks0 = 0; ks0 < nks; ks0 += 4) {
            bf16x8 a0[4], a1[4], bb[4][4];
#pragma unroll
            for (int u = 0; u < 4; ++u) {
                const int ks = ks0 + u < nks ? ks0 + u : nks - 1;
                a0[u] = *(const bf16x8*)(ap + ks * 32); a1[u] = *(const bf16x8*)(ap + (size_t)16 * lda + ks * 32);
#pragma unroll
                for (int nt = 0; nt < 4; ++nt) bb[u][nt] = *(const bf16x8*)(bp + (size_t)nt * 16 * ldbe + ks * 32);
            }
            __builtin_amdgcn_s_setprio(1);
#pragma unroll
            for (int u = 0; u < 4; ++u) {
                if (ks0 + u < nks) {
#pragma unroll
                    for (int nt = 0; nt < 4; ++nt) {
                        acc[0][nt] = __builtin_amdgcn_mfma_f32_16x16x32_bf16(a0[u], bb[u][nt], acc[0][nt], 0, 0, 0);
                        acc[1][nt] = __builtin_amdgcn_mfma_f32_16x16x32_bf16(a1[u], bb[u][nt], acc[1][nt], 0, 0, 0);
                    }
                }
            }
            __builtin_amdgcn_s_setprio(0);
        }
        __syncthreads();
#pragma unroll
        for (int mt = 0; mt < 2; ++mt)
#pragma unroll
            for (int nt = 0; nt < 4; ++nt)
#pragma unroll
                for (int r = 0; r < 4; ++r) red[w * 2048 + (mt * 16 + fq * 4 + r) * 64 + nt * 16 + fr] = acc[mt][nt][r];
        __syncthreads();
        f32x4 s = (f32x4){0.f, 0.f, 0.f, 0.f};
#pragma unroll
        for (int ww = 0; ww < 8; ++ww) s += *(const LAS f32x4*)(red + ww * 2048 + (tid >> 4) * 64 + (tid & 15) * 4);
        if constexpr (Epi::NORM) E(row0 + (tid >> 4), col0 + (tid & 15) * 4, s, tile & 15, lane); else E(row0 + (tid >> 4), col0 + (tid & 15) * 4, s);
    }
    __syncthreads();
}

template <int KT>
__device__ __forceinline__ void tr_job(LAS float* tl, const float* src, int ld, int col0, int ncols, int K, bf16_t* dst, int drow0, int dstep, int& base, int G, int wid, int dld = 0) {
    constexpr int NL = KT / 64;
    const int nct = ncols / 32, nkt = K / KT, ntiles = nct * nkt;
    const int first = ((wid - base) % G + G) % G;
    const int tidx = tid_l();
    f32x4 cur[NL], nxt[NL];
    if (first < ntiles) {
        const int ct = first % nct, kt = first / nct;
#pragma unroll
        for (int i = 0; i < NL; ++i) { const int idx = tidx + i * 512, kk = idx >> 3, c4 = idx & 7; cur[i] = __builtin_nontemporal_load((const f32x4*)(src + (size_t)(kt * KT + kk) * ld + col0 + ct * 32 + c4 * 4)); }
    }
    for (int tile = first; tile < ntiles; tile += G) {
        const int ct = tile % nct, kt = tile / nct;
        const int n0 = ct * 32, k0 = kt * KT;
        {
            const int tn = tile + G < ntiles ? tile + G : tile;
            const int ct2 = tn % nct, kt2 = tn / nct;
#pragma unroll
            for (int i = 0; i < NL; ++i) { const int idx = tidx + i * 512, kk = idx >> 3, c4 = idx & 7; nxt[i] = __builtin_nontemporal_load((const f32x4*)(src + (size_t)(kt2 * KT + kk) * ld + col0 + ct2 * 32 + c4 * 4)); }
        }
#pragma unroll
        for (int i = 0; i < NL; ++i) {
            const int idx = tidx + i * 512, kk = idx >> 3, c4 = idx & 7;
            LAS float* q = tl + (c4 * 4) * (KT + 4) + kk; q[0] = cur[i][0]; q[KT + 4] = cur[i][1]; q[2 * (KT + 4)] = cur[i][2]; q[3 * (KT + 4)] = cur[i][3];
        }
        __syncthreads();
#pragma unroll
        for (int j = 0; j < KT / 128; ++j) {
            const int o = tidx + j * 512, n = o / (KT / 8), kq = o % (KT / 8);
            const f32x4 fa = *(const LAS f32x4*)(tl + n * (KT + 4) + kq * 8), fb = *(const LAS f32x4*)(tl + n * (KT + 4) + kq * 8 + 4);
            const float f[8] = {fa[0], fa[1], fa[2], fa[3], fb[0], fb[1], fb[2], fb[3]};
            const int drow = dstep ? drow0 + (n0 + n) * dstep : drow0 + ((n0 + n) >> 7) * 256 + ((n0 + n) & 127);
            *(u32x4*)(dst + (size_t)drow * (dld ? dld : K) + k0 + kq * 8) = pack8(f);
        }
        __syncthreads();
#pragma unroll
        for (int i = 0; i < NL; ++i) cur[i] = nxt[i];
    }
    base = (base + ntiles) % G;
}

__device__ __forceinline__ void prep_dn1(const Params& p, LAS unsigned char* lds, int nw, int wid) {
    int base = 0;
    tr_job<256>((LAS float*)lds, p.in[10], DM, 0, DM, DFF, (bf16_t*)(p.ws + WS_DN1), 0, 1, base, nw, wid);
}
__device__ __forceinline__ void prep_late(const Params& p, LAS unsigned char* lds, int nw, int wid) {
    LAS float* tl = (LAS float*)lds; unsigned char* ws = p.ws;
    int base = 0;
    tr_job<256>(tl, p.in[27], DM, 0, DM, DM, (bf16_t*)(ws + WS_PRG), 0, 1, base, nw, wid, 3072);
    tr_job<256>(tl, p.in[28], DM, 0, DM, 2048, (bf16_t*)(ws + WS_PRG) + 1024, 0, 1, base, nw, wid, 3072);
    tr_job<256>(tl, p.in[29], DM, 0, DM, DM, (bf16_t*)(ws + WS_OUT), 0, 1, base, nw, wid);
    tr_job<256>(tl, p.in[32], DFF, 0, DFF, DM, (bf16_t*)(ws + WS_UP2), 0, 0, base, nw, wid);
    tr_job<256>(tl, p.in[33], DFF, 0, DFF, DM, (bf16_t*)(ws + WS_UP2), 128, 0, base, nw, wid);
    tr_job<256>(tl, p.in[34], DM, 0, DM, DFF, (bf16_t*)(ws + WS_DN2), 0, 1, base, nw, wid);
}
__device__ __forceinline__ void phase_prep(const Params& p, LAS unsigned char* lds) {
    LAS float* tl = (LAS float*)lds;
    int base = 0;
    unsigned char* ws = p.ws;
    const int G = gdim_l(), bid = bid_l();
    tr_job<256>(tl, p.in[8], DFF, 0, DFF, DM, (bf16_t*)(ws + WS_UP1), 0, 0, base, G, bid);
    tr_job<256>(tl, p.in[9], DFF, 0, DFF, DM, (bf16_t*)(ws + WS_UP1), 128, 0, base, G, bid);
    tr_job<256>(tl, p.in[13], 10272, 0, 8192, DM, (bf16_t*)(ws + WS_IN), 0, 1, base, G, bid);
    tr_job<256>(tl, p.in[13], 10272, 8224, 2048, DM, (bf16_t*)(ws + WS_IN), 8192, 1, base, G, bid);
    tr_job<256>(tl, p.in[13], 10272, 8192, 32, DM, (bf16_t*)(ws + WS_IN), 10240, 1, base, G, bid);
    for (int hb = 0; hb < 8; ++hb) {
        tr_job<128>(tl, p.in[16] + hb * 16384, 128, 0, 128, 128, (bf16_t*)(ws + WS_GA) + hb * 16384, 0, 1, base, G, bid);
        tr_job<128>(tl, p.in[18] + hb * 16384, 128, 0, 128, 128, (bf16_t*)(ws + WS_GX) + hb * 16384, 0, 1, base, G, bid);
    }
    if (G != 256) { prep_dn1(p, lds, G, bid); prep_late(p, lds, G, bid); }
    {
        u32x4* z = (u32x4*)((bf16_t*)(ws + WS_IN) + (size_t)10272 * DM);
        const int n16 = 224 * DM * 2 / 16;
        unsigned z0 = 0u; asm volatile("" : "+v"(z0));
        const u32x4 zz = {z0, z0, z0, z0};
        for (int i = bid_l() * 512 + tid_l(); i < n16; i += gdim_l() * 512) z[i] = zz;
    }
    {
        u32x4* z = (u32x4*)(ws + WS_SLOTS);
        const int n16 = (int)(((size_t)2 * MP * 4 * 8 + (size_t)2 * MS * 16 * 8) / 16);
        unsigned z0 = 0u; asm volatile("" : "+v"(z0));
        const u32x4 zz = {z0, z0, z0, z0};
        for (int i = bid_l() * 512 + tid_l(); i < n16; i += gdim_l() * 512) z[i] = zz;
    }
    {
        const int tq = tid_l(), lane = tq & 63, wv = __builtin_amdgcn_readfirstlane(tq >> 6);
        const float* w = p.in[6];
        bf16_t* xn = (bf16_t*)(ws + WS_XN);
        const int rstep = gdim_l() * 8;
        for (int rowa = bid_l() * 8 + wv; rowa < MTOT; rowa += 2 * rstep) {
            float4 v[2][4]; float ss[2] = {0.f, 0.f};
#pragma unroll
            for (int q = 0; q < 2; ++q) {
                const int row = rowa + q * rstep < MTOT ? rowa + q * rstep : rowa;
                const float* xr = row < MP ? p.in[0] + (size_t)row * DM : p.in[1] + (size_t)(row - MP) * DM;
#pragma unroll
                for (int i = 0; i < 4; ++i) v[q][i] = *(const float4*)(xr + i * 256 + lane * 4);
            }
#pragma unroll
            for (int q = 0; q < 2; ++q)
#pragma unroll
                for (int i = 0; i < 4; ++i) ss[q] += v[q][i].x * v[q][i].x + v[q][i].y * v[q][i].y + v[q][i].z * v[q][i].z + v[q][i].w * v[q][i].w;
#pragma unroll
            for (int o = 32; o; o >>= 1) { ss[0] += bperm(ss[0], lane ^ o); ss[1] += bperm(ss[1], lane ^ o); }
#pragma unroll
            for (int q = 0; q < 2; ++q) {
                const int row = rowa + q * rstep;
                if (row < MTOT) {
                    const float r = rsqrtf(ss[q] * (1.f / DM) + 1e-6f);
#pragma unroll
                    for (int i = 0; i < 4; ++i) {
                        const float4 wv4 = *(const float4*)(w + i * 256 + lane * 4);
                        u32x2 o; o[0] = pk_bf16(v[q][i].x * r * wv4.x, v[q][i].y * r * wv4.y); o[1] = pk_bf16(v[q][i].z * r * wv4.z, v[q][i].w * r * wv4.w);
                        *(u32x2*)(xn + (size_t)row * DM + i * 256 + lane * 4) = o;
                    }
                }
            }
        }
    }
}

__device__ __forceinline__ void norm_pass(const Params& p, bool res_from_input, const float* wpost, float scale, const float* wnext, int row_begin, bf16_t* xn) {
    const int tq = tid_l(), lane = tq & 63, wv = __builtin_amdgcn_readfirstlane(tq >> 6);
    const bf16_t* d = (const bf16_t*)(p.ws + WS_D);
    float* y = p.out + O_Y;
    const int rstep = gdim_l() * 8;
    for (int rowa = row_begin + bid_l() * 8 + wv; rowa < MTOT; rowa += 2 * rstep) {
        float4 v[2][4], x[2][4]; float ss[2] = {0.f, 0.f};
#pragma unroll
        for (int q = 0; q < 2; ++q) {
            const int row = rowa + q * rstep;
            if (row < MTOT) {
                const float* rr = res_from_input ? (row < MP ? p.in[0] + (size_t)row * DM : p.in[1] + (size_t)(row - MP) * DM) : y + (size_t)row * DM;
                const bf16_t* dr = d + (size_t)row * DM;
#pragma unroll
                for (int i = 0; i < 4; ++i) { const u32x2 dv = *(const u32x2*)(dr + i * 256 + lane * 4); v[q][i] = make_float4(bflo(dv[0]), bfhi(dv[0]), bflo(dv[1]), bfhi(dv[1])); x[q][i] = *(const float4*)(rr + i * 256 + lane * 4); }
            } else {
#pragma unroll
                for (int i = 0; i < 4; ++i) { v[q][i] = make_float4(0.f, 0.f, 0.f, 0.f); x[q][i] = make_float4(0.f, 0.f, 0.f, 0.f); }
            }
        }
#pragma unroll
        for (int q = 0; q < 2; ++q)
#pragma unroll
            for (int i = 0; i < 4; ++i) ss[q] += v[q][i].x * v[q][i].x + v[q][i].y * v[q][i].y + v[q][i].z * v[q][i].z + v[q][i].w * v[q][i].w;
#pragma unroll
        for (int o = 32; o; o >>= 1) { ss[0] += bperm(ss[0], lane ^ o); ss[1] += bperm(ss[1], lane ^ o); }
        float ss2[2] = {0.f, 0.f};
#pragma unroll
        for (int q = 0; q < 2; ++q) {
            const int row = rowa + q * rstep;
            const float r = rsqrtf(ss[q] * (1.f / DM) + 1e-6f) * scale;
#pragma unroll
            for (int i = 0; i < 4; ++i) {
                const float4 w4 = *(const float4*)(wpost + i * 256 + lane * 4);
                x[q][i].x += v[q][i].x * r * w4.x; x[q][i].y += v[q][i].y * r * w4.y; x[q][i].z += v[q][i].z * r * w4.z; x[q][i].w += v[q][i].w * r * w4.w;
                ss2[q] += x[q][i].x * x[q][i].x + x[q][i].y * x[q][i].y + x[q][i].z * x[q][i].z + x[q][i].w * x[q][i].w;
                if (row < MTOT) *(float4*)(y + (size_t)row * DM + i * 256 + lane * 4) = x[q][i];
            }
        }
        if (wnext) {
#pragma unroll
            for (int o = 32; o; o >>= 1) { ss2[0] += bperm(ss2[0], lane ^ o); ss2[1] += bperm(ss2[1], lane ^ o); }
#pragma unroll
            for (int q = 0; q < 2; ++q) {
                const int row = rowa + q * rstep;
                const float r2 = rsqrtf(ss2[q] * (1.f / DM) + 1e-6f);
                if (row < MTOT) {
#pragma unroll
                    for (int i = 0; i < 4; ++i) {
                        const float4 w4 = *(const float4*)(wnext + i * 256 + lane * 4);
                        u32x2 o; o[0] = pk_bf16(x[q][i].x * r2 * w4.x, x[q][i].y * r2 * w4.y); o[1] = pk_bf16(x[q][i].z * r2 * w4.z, x[q][i].w * r2 * w4.w);
                        *(u32x2*)(xn + (size_t)row * DM + i * 256 + lane * 4) = o;
                    }
                }
            }
        }
    }
}

struct RgPre { u32x4 raw[7]; };
__device__ __forceinline__ void rg_prefetch(const Params& p, int T, int hb, RgPre& pre) {
    const int tid = tid_l();
    const bf16_t* proj = (const bf16_t*)(p.ws + WS_PROJ);
    int vo = hb * 128 + (tid & 15) * 8; asm volatile("" : "+v"(vo));
    const int row0 = T * 128 + (tid >> 4) * 4 - 3;
#pragma unroll
    for (int r = 0; r < 7; ++r) { const int row = row0 + r < 0 ? 0 : row0 + r; pre.raw[r] = *(const u32x4*)(proj + (size_t)row * LDP + vo); }
}
__device__ __forceinline__ void rg_item(const Params& p, LAS unsigned char* lds, int T, int hb, RgPre& pre, int Tn, int hbn) {
    const int tid = tid_l(), lane = tid & 63, w = __builtin_amdgcn_readfirstlane(tid >> 6), fr = lane & 15, fq = lane >> 4;
    const int r0 = T * 128; const bool isS = r0 >= MP;
    bf16_t* proj = (bf16_t*)(p.ws + WS_PROJ);
    LAS bf16_t* As = (LAS bf16_t*)lds;
    const bf16_t* ga0 = (const bf16_t*)(p.ws + WS_GA) + hb * 16384;
    const bf16_t* gx0 = (const bf16_t*)(p.ws + WS_GX) + hb * 16384;
    bf16x8 bfa[4], bfx[4];
#pragma unroll
    for (int ks = 0; ks < 4; ++ks) {
        bfa[ks] = *(const bf16x8*)(ga0 + (w * 16 + fr) * 128 + ks * 32 + fq * 8);
        bfx[ks] = *(const bf16x8*)(gx0 + (w * 16 + fr) * 128 + ks * 32 + fq * 8);
    }
    {
        const int cgp = tid & 15, t0 = (tid >> 4) * 4;
        const int ch0 = hb * 128 + cgp * 8;
        float f[7][8];
#pragma unroll
        for (int r = 0; r < 7; ++r) unpack8(pre.raw[r], f[r]);
        if (!isS) {
            if ((T & 15) == 0 && t0 == 0) {
#pragma unroll
                for (int r = 0; r < 3; ++r)
#pragma unroll
                    for (int e = 0; e < 8; ++e) f[r][e] = 0.f;
            }
        } else {
            const int seq = ((r0 - MP) >> 2) + (tid >> 4);
#pragma unroll
            for (int r = 0; r < 3; ++r) {
                const float* sp = p.in[3] + ((size_t)seq * 3 + r) * 1024 + ch0;
                const float4 a = *(const float4*)sp, b = *(const float4*)(sp + 4);
                f[r][0] = a.x; f[r][1] = a.y; f[r][2] = a.z; f[r][3] = a.w; f[r][4] = b.x; f[r][5] = b.y; f[r][6] = b.z; f[r][7] = b.w;
            }
        }
        float bias[8];
        { const float4 a = *(const float4*)(p.in[15] + ch0), b = *(const float4*)(p.in[15] + ch0 + 4);
          bias[0] = a.x; bias[1] = a.y; bias[2] = a.z; bias[3] = a.w; bias[4] = b.x; bias[5] = b.y; bias[6] = b.z; bias[7] = b.w; }
        float av[4][8];
#pragma unroll
        for (int r = 0; r < 4; ++r)
#pragma unroll
            for (int e = 0; e < 8; ++e) av[r][e] = bias[e];
#pragma unroll
        for (int k = 0; k < 4; ++k) {
            const float4 a = *(const float4*)(p.in[14] + k * 1024 + ch0), b = *(const float4*)(p.in[14] + k * 1024 + ch0 + 4);
            const float wk[8] = {a.x, a.y, a.z, a.w, b.x, b.y, b.z, b.w};
#pragma unroll
            for (int r = 0; r < 4; ++r)
#pragma unroll
                for (int e = 0; e < 8; ++e) av[r][e] += wk[e] * f[r + k][e];
        }
#pragma unroll
        for (int r = 0; r < 4; ++r) *(LAS u32x4*)(As + (t0 + r) * 136 + cgp * 8) = pack8(av[r]);
    }
    rg_prefetch(p, Tn, hbn, pre);
    lds_barrier();
    f32x4 aa[8], ax[8];
    __builtin_amdgcn_s_setprio(1);
#pragma unroll
    for (int m = 0; m < 8; ++m) {
        aa[m] = (f32x4){0.f, 0.f, 0.f, 0.f}; ax[m] = (f32x4){0.f, 0.f, 0.f, 0.f};
#pragma unroll
        for (int ks = 0; ks < 4; ++ks) {
            const bf16x8 af = *(const LAS bf16x8*)(As + (m * 16 + fr) * 136 + ks * 32 + fq * 8);
            aa[m] = __builtin_amdgcn_mfma_f32_16x16x32_bf16(af, bfa[ks], aa[m], 0, 0, 0);
            ax[m] = __builtin_amdgcn_mfma_f32_16x16x32_bf16(af, bfx[ks], ax[m], 0, 0, 0);
        }
    }
    __builtin_amdgcn_s_setprio(0);
    const int ch = hb * 128 + w * 16 + fr;
    const float bav = p.in[17][ch], bxv = p.in[19][ch];
    const float sp8 = -8.f * softplusf_(-p.in[20][ch]);
    if (!isS) {
        unsigned* rgt = (unsigned*)(p.ws + WS_D);
        float At = 1.f, Ht = 0.f;
#pragma unroll
        for (int m = 0; m < 8; ++m) {
            float A4 = 1.f, H4 = 0.f;
#pragma unroll
            for (int j = 0; j < 4; ++j) {
                const int t = m * 16 + fq * 4 + j;
                const float xcv = bf2f(As[t * 136 + w * 16 + fr]);
                const float gav = sigmoidf_(aa[m][j] + bav), gxv = sigmoidf_(ax[m][j] + bxv);
                float la = bf2f(f2bf(sp8 * gav));
                float a = __expf(la);
                float mult = sqrtf(fmaxf(1.f - a * a, 0.f));
                if ((T & 15) == 0 && t == 0) { a = 0.f; la = -__builtin_inff(); mult = 1.f; }
                const unsigned pkv = pk_bf16(la, xcv * gxv * mult);
                const float uu = bfhi(pkv);
                __builtin_nontemporal_store(pkv, rgt + (size_t)(r0 + t) * 1024 + ch);
                H4 = a * H4 + uu; A4 *= a;
            }
            { const float Ao = bperm(A4, lane ^ 16), Ho = bperm(H4, lane ^ 16);
              if (fq & 1) { H4 = A4 * Ho + H4; } else { H4 = Ao * H4 + Ho; } A4 *= Ao; }
            { const float Ao = bperm(A4, lane ^ 32), Ho = bperm(H4, lane ^ 32);
              if (fq & 2) { H4 = A4 * Ho + H4; } else { H4 = Ao * H4 + Ho; } A4 *= Ao; }
            Ht = A4 * Ht + H4; At *= A4;
        }
        if (fq == 0) { float2* tot = (float2*)(p.ws + WS_RGTOT); tot[(size_t)T * 1024 + ch] = make_float2(At, Ht); }
    } else {
        bf16_t gv[8][4]; float h0v[8];
        {
            int vo = (fq * 4) * LDP + 1024 + ch; asm volatile("" : "+v"(vo));
            const bf16_t* gb = proj + (size_t)r0 * LDP;
#pragma unroll
            for (int m = 0; m < 8; ++m) {
                h0v[m] = p.in[2][(size_t)(((r0 - MP) >> 2) + m * 4 + fq) * 1024 + ch];
#pragma unroll
                for (int j = 0; j < 4; ++j) gv[m][j] = gb[vo + (m * 16 + j) * LDP];
            }
        }
#pragma unroll
        for (int m = 0; m < 8; ++m) {
            const int seq = ((r0 - MP) >> 2) + m * 4 + fq;
            float h = h0v[m];
#pragma unroll
            for (int j = 0; j < 4; ++j) {
                const int t = m * 16 + fq * 4 + j;
                const float xcv = bf2f(As[t * 136 + w * 16 + fr]);
                const float gav = sigmoidf_(aa[m][j] + bav), gxv = sigmoidf_(ax[m][j] + bxv);
                const float la = sp8 * gav;
                const float a = __expf(la);
                const float mult = sqrtf(fmaxf(1.f - a * a, 0.f));
                h = a * h + xcv * gxv * mult;
                proj[(size_t)(r0 + t) * LDP + 1024 + ch] = f2bf(h * geluf_(bf2f(gv[m][j])));
            }
            p.out[O_SRGH + (size_t)seq * 1024 + ch] = h;
        }
    }
}


__device__ __forceinline__ void phase_bc(const Params& p) {
    const int tid = tid_l(), G = gdim_l(), bid = bid_l();
    const bf16_t* proj = (const bf16_t*)(p.ws + WS_PROJ);
    const int cgp = tid & 255, half = tid >> 8, ch0 = cgp * 8;
    float wk[4][8], bias[8];
#pragma unroll
    for (int k = 0; k < 4; ++k) {
        const float4 a = *(const float4*)(p.in[21] + k * 4096 + 2048 + ch0), c = *(const float4*)(p.in[21] + k * 4096 + 2048 + ch0 + 4);
        wk[k][0] = a.x; wk[k][1] = a.y; wk[k][2] = a.z; wk[k][3] = a.w; wk[k][4] = c.x; wk[k][5] = c.y; wk[k][6] = c.z; wk[k][7] = c.w;
    }
    { const float4 a = *(const float4*)(p.in[22] + 2048 + ch0), c = *(const float4*)(p.in[22] + 2048 + ch0 + 4);
      bias[0] = a.x; bias[1] = a.y; bias[2] = a.z; bias[3] = a.w; bias[4] = c.x; bias[5] = c.y; bias[6] = c.z; bias[7] = c.w; }
    u32x4 cur[11], nxt[11];
#define BC_LOAD(dst_, j4_) do { \
        const int _it = G == 256 ? (bid & 7) * 128 + (bid >> 3) + 32 * (j4_) : bid + (j4_) * G; \
        const int _row0 = _it * 16 + half * 8 - 3; \
        int _vo = ch0; asm volatile("" : "+v"(_vo)); \
        _Pragma("unroll") for (int r = 0; r < 11; ++r) { const int _row = _row0 + r < 0 ? 0 : _row0 + r; dst_[r] = *(const u32x4*)(proj + (size_t)_row * LDP + 6144 + _vo); } \
    } while (0)
    if (bid < 1024) BC_LOAD(cur, 0);
    for (int j4 = 0; j4 * G + bid < 1024; ++j4) {
        const int it = G == 256 ? (bid & 7) * 128 + (bid >> 3) + 32 * j4 : bid + j4 * G;
        const int row0 = it * 16 + half * 8, b = row0 >> 11, tl = row0 & 2047;
        int vo = ch0; asm volatile("" : "+v"(vo));
        { const int jn = (j4 + 1) * G + bid < 1024 ? j4 + 1 : j4; BC_LOAD(nxt, jn); }
        float o[8][8];
#pragma unroll
        for (int r = 0; r < 8; ++r)
#pragma unroll
            for (int e = 0; e < 8; ++e) o[r][e] = bias[e];
#pragma unroll
        for (int rr = 0; rr < 11; ++rr) {
            float f[8]; unpack8(cur[rr], f);
            if (rr < 3 && tl == 0) {
#pragma unroll
                for (int e = 0; e < 8; ++e) f[e] = 0.f;
            }
#pragma unroll
            for (int k = 0; k < 4; ++k) {
                const int r = rr - k;
                if (r >= 0 && r < 8) {
#pragma unroll
                    for (int e = 0; e < 8; ++e) o[r][e] += wk[k][e] * f[e];
                }
            }
        }
        bf16_t* dst = bc_base(p.ws, b) + (size_t)tl * 2048;
#pragma unroll
        for (int r = 0; r < 8; ++r) {
#pragma unroll
            for (int e = 0; e < 8; ++e) o[r][e] = siluf_(o[r][e]);
            *(u32x4*)(dst + (vo + r * 2048)) = pack8(o[r]);
        }
#pragma unroll
        for (int r = 0; r < 11; ++r) cur[r] = nxt[r];
    }
#undef BC_LOAD
}

__device__ __forceinline__ void conv4_s(const Params& p, const bf16_t* proj, int seq, int rbase, int cidx, float* o) {
    float xin[7];
#pragma unroll
    for (int k = 0; k < 3; ++k) xin[k] = p.in[5][((size_t)seq * 3 + k) * 4096 + cidx];
#pragma unroll
    for (int j = 0; j < 4; ++j) xin[3 + j] = bf2f(proj[(size_t)(rbase + j) * LDP + 4096 + cidx]);
    const float w0 = p.in[21][cidx], w1 = p.in[21][4096 + cidx], w2 = p.in[21][8192 + cidx], w3 = p.in[21][12288 + cidx], b = p.in[22][cidx];
#pragma unroll
    for (int j = 0; j < 4; ++j) o[j] = siluf_(b + w0 * xin[j] + w1 * xin[j + 1] + w2 * xin[j + 2] + w3 * xin[j + 3]);
}
__device__ __forceinline__ void ssd_s_item(const Params& p, LAS float* wl, int seq, int h) {
    const int lane = tid_l() & 63, g = h >> 2;
    const int rbase = MP + seq * 4;
    const int pl = lane >> 4, nl = lane & 15;
    const float* h0p = p.in[4] + ((size_t)seq * 32 + h) * 8192;
    f32x4 hA[4], hB[4];
    { int vo = pl * 128 + nl * 8; asm volatile("" : "+v"(vo));
#pragma unroll
      for (int k = 0; k < 4; ++k) { hA[k] = __builtin_nontemporal_load((const f32x4*)(h0p + vo + k * 512)); hB[k] = __builtin_nontemporal_load((const f32x4*)(h0p + vo + k * 512 + 4)); } }
    bf16_t* proj = (bf16_t*)(p.ws + WS_PROJ);
    const float* DT = (const float*)(p.ws + WS_DT);
    LAS float* xs = wl; LAS float* Bl = wl + 256; LAS float* Cl = wl + 768; LAS float* yo = wl + 1280;
    float xv[4], b0[4], b1[4], c0[4], c1[4];
    conv4_s(p, proj, seq, rbase, h * 64 + lane, xv);
    conv4_s(p, proj, seq, rbase, 2048 + g * 128 + lane, b0);
    conv4_s(p, proj, seq, rbase, 2048 + g * 128 + 64 + lane, b1);
    conv4_s(p, proj, seq, rbase, 3072 + g * 128 + lane, c0);
    conv4_s(p, proj, seq, rbase, 3072 + g * 128 + 64 + lane, c1);
    const float Ah = -__expf(p.in[24][h]), Dh = p.in[25][h];
    float dtv[4], acs[4];
    { float s = 0.f;
#pragma unroll
      for (int j = 0; j < 4; ++j) { dtv[j] = DT[(size_t)(rbase + j) * 32 + h]; s += dtv[j] * Ah; acs[j] = s; } }
#pragma unroll
    for (int j = 0; j < 4; ++j) { xs[j * 64 + lane] = xv[j]; Bl[j * 128 + lane] = b0[j]; Bl[j * 128 + 64 + lane] = b1[j]; Cl[j * 128 + lane] = c0[j]; Cl[j * 128 + 64 + lane] = c1[j]; }
    float yd[4];
#pragma unroll
    for (int i = 0; i < 4; ++i) {
        yd[i] = 0.f;
#pragma unroll
        for (int j = 0; j <= i; ++j) {
            const float cb = wave_sum(c0[i] * b0[j] + c1[i] * b1[j], lane);
            yd[i] += cb * __expf(acs[i] - acs[j]) * dtv[j] * xv[j];
        }
    }
    asm volatile("s_waitcnt lgkmcnt(0)" ::: "memory");
    __builtin_amdgcn_wave_barrier();
    float Cr[4][8], Bw[4][8];
#pragma unroll
    for (int i = 0; i < 4; ++i) {
        const float wj = __expf(acs[3] - acs[i]) * dtv[i];
#pragma unroll
        for (int e = 0; e < 8; ++e) { Cr[i][e] = Cl[i * 128 + nl * 8 + e]; Bw[i][e] = Bl[i * 128 + nl * 8 + e] * wj; }
    }
    const float dec = __expf(acs[3]);
    float* hop = p.out + O_SSSD + ((size_t)seq * 32 + h) * 8192;
#pragma unroll
    for (int hf = 0; hf < 4; ++hf) {
        f32x4 nA[4], nB[4];
        if (hf < 3) {
            int vo = pl * 128 + nl * 8 + (hf + 1) * 2048; asm volatile("" : "+v"(vo));
#pragma unroll
            for (int k = 0; k < 4; ++k) { nA[k] = __builtin_nontemporal_load((const f32x4*)(h0p + vo + k * 512)); nB[k] = __builtin_nontemporal_load((const f32x4*)(h0p + vo + k * 512 + 4)); }
        }
#pragma unroll
        for (int k = 0; k < 4; ++k) {
            const int pp = pl + 4 * (hf * 4 + k);
            const f32x4 ha = hA[k], hb = hB[k];
            float part[4];
#pragma unroll
            for (int i = 0; i < 4; ++i) {
                float s = 0.f;
#pragma unroll
                for (int e = 0; e < 4; ++e) s += Cr[i][e] * ha[e] + Cr[i][4 + e] * hb[e];
                s += bperm(s, lane ^ 1); s += bperm(s, lane ^ 2); s += bperm(s, lane ^ 4); s += bperm(s, lane ^ 8);
                part[i] = s;
            }
            if (nl == 0) {
#pragma unroll
                for (int i = 0; i < 4; ++i) yo[i * 64 + pp] = part[i] * __expf(acs[i]);
            }
            float xj[4];
#pragma unroll
            for (int j = 0; j < 4; ++j) xj[j] = xs[j * 64 + pp];
            f32x4 na, nb;
#pragma unroll
            for (int e = 0; e < 4; ++e) {
                float s0 = dec * ha[e], s1 = dec * hb[e];
#pragma unroll
                for (int j = 0; j < 4; ++j) { s0 += Bw[j][e] * xj[j]; s1 += Bw[j][4 + e] * xj[j]; }
                na[e] = s0; nb[e] = s1;
            }
            __builtin_nontemporal_store(na, (f32x4*)(hop + pp * 128 + nl * 8)); __builtin_nontemporal_store(nb, (f32x4*)(hop + pp * 128 + nl * 8 + 4));
        }
        if (hf < 3) {
#pragma unroll
            for (int k = 0; k < 4; ++k) { hA[k] = nA[k]; hB[k] = nB[k]; }
        }
    }
    asm volatile("s_waitcnt lgkmcnt(0)" ::: "memory");
    __builtin_amdgcn_wave_barrier();
#pragma unroll
    for (int i = 0; i < 4; ++i) {
        bf16_t* zp = proj + (size_t)(rbase + i) * LDP + 2048 + h * 64 + lane;
        const float y = yd[i] + yo[i * 64 + lane] + Dh * xv[i];
        *zp = f2bf(y * siluf_(bf2f(*zp)));
    }
    asm volatile("s_waitcnt lgkmcnt(0)" ::: "memory");
    __builtin_amdgcn_wave_barrier();
}

constexpr int SP_CS = 0, SP_BS = 34816, SP_BT = 69632, SP_XT = 104448, SP_SS = 121856, SP_SC = 139264, SP_WT = 142336;


struct SsdPre { u32x4 c[4], b[4], x[5]; u32x2 z[4]; float d0, d1; };

template <int NROW>
__device__ __forceinline__ void ssd_conv(const u32x4* raw, const LAS float* wts, float (&o)[NROW][8]) {
#pragma unroll
    for (int r = 0; r < NROW; ++r)
#pragma unroll
        for (int e = 0; e < 8; ++e) o[r][e] = wts[4 * 320 + e];
#pragma unroll
    for (int k = 0; k < 4; ++k) {
        float wk[8];
#pragma unroll
        for (int e = 0; e < 8; ++e) wk[e] = wts[k * 320 + e];
#pragma unroll
        for (int r = 0; r < NROW; ++r) {
            float f[8]; unpack8(raw[r + k], f);
#pragma unroll
            for (int e = 0; e < 8; ++e) o[r][e] += wk[e] * f[e];
        }
    }
#pragma unroll
    for (int r = 0; r < NROW; ++r)
#pragma unroll
        for (int e = 0; e < 8; ++e) o[r][e] = siluf_(o[r][e]);
}

__device__ __forceinline__ void ssd_p_item(const Params& p, LAS unsigned char* lds, int b, int h) {
    const int tid = tid_l(), lane = tid & 63, w = __builtin_amdgcn_readfirstlane(tid >> 6), fr = lane & 15, fq = lane >> 4, g = h >> 2;
    LAS bf16_t* Cs = (LAS bf16_t*)(lds + SP_CS); LAS bf16_t* Bs = (LAS bf16_t*)(lds + SP_BS); LAS bf16_t* Bt = (LAS bf16_t*)(lds + SP_BT);
    LAS bf16_t* Xt = (LAS bf16_t*)(lds + SP_XT); LAS bf16_t* Ss = (LAS bf16_t*)(lds + SP_SS);
    LAS float* scb = (LAS float*)(lds + SP_SC);
    LAS float* wts = (LAS float*)(lds + SP_WT);
    bf16_t* proj = (bf16_t*)(p.ws + WS_PROJ);
    const float* DT = (const float*)(p.ws + WS_DT);
    const float Ah = -__expf(p.in[24][h]), Dh = p.in[25][h];
    const bf16_t* bcimg = bc_base(p.ws, b);
    const int cg16 = (w & 3) * 4 + (lane & 3), t0 = ((w >> 2) * 16 + (lane >> 2)) * 4, n8 = cg16 * 8;
    const int cg8 = (w & 3) * 2 + (lane & 1), t0x = ((w >> 2) * 32 + (lane >> 1)) * 2, p8 = cg8 * 8;
    SsdPre pre;
    const u32x4 zero4 = {0u, 0u, 0u, 0u};
#define SSD_PREFETCH_(c_, FIRST) do { \
        const int _r0 = b * 2048 + (c_) * 128; \
        const bf16_t* _rb3 = proj + ((long)_r0 - 3) * LDP + 4096; \
        const bf16_t* _bc = bcimg + (size_t)((c_) * 128) * 2048; \
        int _vc = t0 * 2048 + 1024 + g * 128 + n8, _vx = t0x * LDP + h * 64 + p8; \
        asm volatile("" : "+v"(_vc), "+v"(_vx)); \
        _Pragma("unroll") for (int r = 0; r < 4; ++r) { pre.c[r] = *(const u32x4*)(_bc + (_vc + r * 2048)); pre.b[r] = *(const u32x4*)(_bc + (_vc + r * 2048 - 1024)); } \
        _Pragma("unroll") for (int r = 0; r < 5; ++r) { \
            if (FIRST && t0x - 3 + r < 0) pre.x[r] = zero4; else pre.x[r] = *(const u32x4*)(_rb3 + (_vx + r * LDP)); } \
        { int _vd = 2 * lane * 32 + h; asm volatile("" : "+v"(_vd)); const float* _dp = DT + (size_t)_r0 * 32; pre.d0 = _dp[_vd]; pre.d1 = _dp[_vd + 32]; } \
    } while (0)
#define SSD_PREFETCH_Z(c_) do { \
        const bf16_t* _zb = proj + (size_t)(b * 2048 + (c_) * 128) * LDP + 2048 + h * 64; \
        int _vz = (16 * w + fr) * LDP + fq * 4; asm volatile("" : "+v"(_vz)); \
        _Pragma("unroll") for (int pt = 0; pt < 4; ++pt) pre.z[pt] = *(const u32x2*)(_zb + _vz + pt * 16); \
    } while (0)
    pre.d0 = 0.f; pre.d1 = 0.f;
    SSD_PREFETCH_(0, true);
    SSD_PREFETCH_Z(0);
    lds_barrier();
    for (int i = tid; i < 1600; i += 512) {
        const int k = i / 320, c = i % 320;
        const int ch = c < 64 ? h * 64 + c : (c < 192 ? 2048 + g * 128 + (c - 64) : 3072 + g * 128 + (c - 192));
        wts[i] = k < 4 ? p.in[21][k * 4096 + ch] : p.in[22][ch];
    }
    for (int i = tid; i < 64 * 136 / 2; i += 512) ((LAS unsigned*)Ss)[i] = 0u;
    f32x4 accS[4];
#pragma unroll
    for (int pt = 0; pt < 4; ++pt) accS[pt] = (f32x4){0.f, 0.f, 0.f, 0.f};
#define SSD_SCAN(par) do { if (w == 0) { \
        LAS float* _a = scb + (par) * 384; \
        const float d0 = pre.d0, d1 = pre.d1; const float a0 = d0 * Ah, a1 = d1 * Ah; \
        float s = a0 + a1; \
        _Pragma("unroll") for (int o = 1; o < 64; o <<= 1) { const float tmp = bperm(s, lane - o); if (lane >= o) s += tmp; } \
        const float tot = bperm(s, 63); \
        _a[2 * lane] = s - a1; _a[2 * lane + 1] = s; _a[128 + 2 * lane] = d0; _a[128 + 2 * lane + 1] = d1; \
        _a[256 + 2 * lane] = __expf(tot - (s - a1)) * d0; _a[256 + 2 * lane + 1] = __expf(tot - s) * d1; } } while (0)
    SSD_SCAN(0);
    for (int c = 0; c < 16; ++c) {
        LAS float* acs = scb + (c & 1) * 384; LAS float* dtv = acs + 128; LAS float* wjs = acs + 256;
        const int r0 = b * 2048 + c * 128;
        int lane_c = lane; asm volatile("" : "+v"(lane_c));
        const int lane = lane_c, fr = lane & 15, fq = lane >> 4;
        const int cg16 = (w & 3) * 4 + (lane & 3), t0 = ((w >> 2) * 16 + (lane >> 2)) * 4, n8 = cg16 * 8;
        const int cg8 = (w & 3) * 2 + (lane & 1), t0x = ((w >> 2) * 32 + (lane >> 1)) * 2, p8 = cg8 * 8;
        lds_barrier();
#pragma unroll
        for (int pt = 0; pt < 4; ++pt) {
            u32x2 o; o[0] = pk_bf16(accS[pt][0], accS[pt][1]); o[1] = pk_bf16(accS[pt][2], accS[pt][3]);
            *(LAS u32x2*)(Ss + (pt * 16 + fr) * 136 + 16 * w + fq * 4) = o;
        }
        {
            float wj[4];
#pragma unroll
            for (int r = 0; r < 4; ++r) { *(LAS u32x4*)(Cs + (t0 + r) * 136 + n8) = pre.c[r]; *(LAS u32x4*)(Bs + (t0 + r) * 136 + n8) = pre.b[r]; wj[r] = wjs[t0 + r]; }
            float o[4][8];
#pragma unroll
            for (int r = 0; r < 4; ++r) unpack8(pre.b[r], o[r]);
#pragma unroll
            for (int e = 0; e < 8; ++e) {
                u32x2 v; v[0] = pk_bf16(o[0][e] * wj[0], o[1][e] * wj[1]); v[1] = pk_bf16(o[2][e] * wj[2], o[3][e] * wj[3]);
                *(LAS u32x2*)(Bt + (n8 + e) * 136 + t0) = v;
            }
        }
        {
            float o[2][8];
            ssd_conv<2>(pre.x, wts + p8, o);
#pragma unroll
            for (int e = 0; e < 8; ++e) *(LAS unsigned*)(Xt + (p8 + e) * 136 + t0x) = pk_bf16(o[0][e], o[1][e]);
        }
        { const int cn = c + 1 < 16 ? c + 1 : 15; SSD_PREFETCH_(cn, false); }
        lds_barrier();
        bf16x8 cfr[4];
#pragma unroll
        for (int ks = 0; ks < 4; ++ks) cfr[ks] = *(const LAS bf16x8*)(Cs + (16 * w + fr) * 136 + ks * 32 + fq * 8);
        f32x4 cb[8];
        __builtin_amdgcn_s_setprio(1);
#pragma unroll
        for (int jt = 0; jt < 8; ++jt) {
            cb[jt] = (f32x4){0.f, 0.f, 0.f, 0.f};
            if (jt <= w) {
#pragma unroll
                for (int ks = 0; ks < 4; ++ks) {
                    const bf16x8 bfr = *(const LAS bf16x8*)(Bs + (jt * 16 + fr) * 136 + ks * 32 + fq * 8);
                    cb[jt] = __builtin_amdgcn_mfma_f32_16x16x32_bf16(bfr, cfr[ks], cb[jt], 0, 0, 0);
                }
            }
        }
        __builtin_amdgcn_s_setprio(0);
        {
            const int i = 16 * w + fr;
            const float ai = acs[i];
#pragma unroll
            for (int jt = 0; jt < 8; ++jt) {
                const int j0 = jt * 16 + fq * 4;
                const f32x4 aj = *(const LAS f32x4*)(acs + j0), dj = *(const LAS f32x4*)(dtv + j0);
                float v[4];
#pragma unroll
                for (int r = 0; r < 4; ++r) v[r] = (jt <= w && j0 + r <= i) ? cb[jt][r] * __expf(ai - aj[r]) * dj[r] : 0.f;
                u32x2 o; o[0] = pk_bf16(v[0], v[1]); o[1] = pk_bf16(v[2], v[3]);
                *(LAS u32x2*)(Cs + i * 136 + j0) = o;
            }
        }
        asm volatile("s_waitcnt lgkmcnt(0)" ::: "memory");
        __builtin_amdgcn_wave_barrier();
        f32x4 yd[4], yo[4];
#pragma unroll
        for (int pt = 0; pt < 4; ++pt) { yd[pt] = (f32x4){0.f, 0.f, 0.f, 0.f}; yo[pt] = (f32x4){0.f, 0.f, 0.f, 0.f}; }
        __builtin_amdgcn_s_setprio(1);
#pragma unroll
        for (int ks = 0; ks < 4; ++ks) {
            if (ks <= (w >> 1)) {
                const bf16x8 wfr = *(const LAS bf16x8*)(Cs + (16 * w + fr) * 136 + ks * 32 + fq * 8);
#pragma unroll
                for (int pt = 0; pt < 4; ++pt) {
                    const bf16x8 xfr = *(const LAS bf16x8*)(Xt + (pt * 16 + fr) * 136 + ks * 32 + fq * 8);
                    yd[pt] = __builtin_amdgcn_mfma_f32_16x16x32_bf16(xfr, wfr, yd[pt], 0, 0, 0);
                }
            }
        }
#pragma unroll
        for (int ks = 0; ks < 4; ++ks)
#pragma unroll
            for (int pt = 0; pt < 4; ++pt) {
                const bf16x8 sfr = *(const LAS bf16x8*)(Ss + (pt * 16 + fr) * 136 + ks * 32 + fq * 8);
                yo[pt] = __builtin_amdgcn_mfma_f32_16x16x32_bf16(sfr, cfr[ks], yo[pt], 0, 0, 0);
            }
        __builtin_amdgcn_s_setprio(0);
        {
            bf16_t* zb = proj + (size_t)r0 * LDP + 2048 + h * 64;
            int vz = (16 * w + fr) * LDP + fq * 4; asm volatile("" : "+v"(vz));
            const int i = 16 * w + fr;
            const float ea = __expf(acs[i]);
#pragma unroll
            for (int pt = 0; pt < 4; ++pt) {
                const float z0 = bflo(pre.z[pt][0]), z1 = bfhi(pre.z[pt][0]), z2 = bflo(pre.z[pt][1]), z3 = bfhi(pre.z[pt][1]);
                const int pc = pt * 16 + fq * 4;
                const float y0 = yd[pt][0] + ea * yo[pt][0] + Dh * bf2f(Xt[(pc + 0) * 136 + i]);
                const float y1 = yd[pt][1] + ea * yo[pt][1] + Dh * bf2f(Xt[(pc + 1) * 136 + i]);
                const float y2 = yd[pt][2] + ea * yo[pt][2] + Dh * bf2f(Xt[(pc + 2) * 136 + i]);
                const float y3 = yd[pt][3] + ea * yo[pt][3] + Dh * bf2f(Xt[(pc + 3) * 136 + i]);
                u32x2 o; o[0] = pk_bf16(y0 * siluf_(z0), y1 * siluf_(z1)); o[1] = pk_bf16(y2 * siluf_(z2), y3 * siluf_(z3));
                *(u32x2*)(zb + vz + pt * 16) = o;
            }
        }
        { const int cn = c + 1 < 16 ? c + 1 : 15; SSD_PREFETCH_Z(cn); }
        {
            const float dec = __expf(acs[127]);
            __builtin_amdgcn_s_setprio(1);
            bf16x8 btf[4];
#pragma unroll
            for (int ks = 0; ks < 4; ++ks) btf[ks] = *(const LAS bf16x8*)(Bt + (16 * w + fr) * 136 + ks * 32 + fq * 8);
#pragma unroll
            for (int pt = 0; pt < 4; ++pt) {
                accS[pt] *= dec;
#pragma unroll
                for (int ks = 0; ks < 4; ++ks) {
                    const bf16x8 xfr = *(const LAS bf16x8*)(Xt + (pt * 16 + fr) * 136 + ks * 32 + fq * 8);
                    accS[pt] = __builtin_amdgcn_mfma_f32_16x16x32_bf16(btf[ks], xfr, accS[pt], 0, 0, 0);
                }
            }
        }
        __builtin_amdgcn_s_setprio(0);
        SSD_SCAN((c + 1) & 1);
    }
#undef SSD_SCAN
#undef SSD_PREFETCH_
#undef SSD_PREFETCH_Z
    float* so = p.out + O_PSSD + ((size_t)b * 32 + h) * 8192;
#pragma unroll
    for (int pt = 0; pt < 4; ++pt) __builtin_nontemporal_store(accS[pt], (f32x4*)(so + (pt * 16 + fr) * 128 + 16 * w + fq * 4));
    lds_barrier();
}

__device__ __forceinline__ void phase_m1(const Params& p, LAS unsigned char* lds) {
    const int G = gdim_l(), bid = bid_l();
    for (int it = bid; it < 256; it += G) ssd_p_item(p, lds, it & 7, it >> 3);
    __syncthreads();
    const int wv = __builtin_amdgcn_readfirstlane(tid_l() >> 6);
    for (int it = bid * 8 + wv; it < 4096; it += G * 8) ssd_s_item(p, (LAS float*)lds + wv * 1536, it >> 5, it & 31);
}

__device__ __forceinline__ void phase_m3(const Params& p) {
    const int tid = tid_l(), G = gdim_l(), bid = bid_l();
    bf16_t* proj = (bf16_t*)(p.ws + WS_PROJ);
    const unsigned* rgt = (const unsigned*)(p.ws + WS_D);
    const float2* tot = (const float2*)(p.ws + WS_RGTOT);
    for (int it = bid; it < 256; it += G) {
        const int T = it >> 1, ch = (it & 1) * 512 + tid, r0 = T * 128;
        float h = 0.f;
        for (int c = (T & ~15); c < T; ++c) { const float2 ah = tot[(size_t)c * 1024 + ch]; h = ah.x * h + ah.y; }
        const unsigned* rp = rgt + (size_t)r0 * 1024;
        bf16_t* gp = proj + (size_t)r0 * LDP + 1024;
        unsigned pk[3][16]; bf16_t gg[3][16];
        int vo = ch; asm volatile("" : "+v"(vo));
#pragma unroll
        for (int bb = 0; bb < 2; ++bb)
#pragma unroll
            for (int i = 0; i < 16; ++i) { pk[bb][i] = rp[vo + (bb * 16 + i) * 1024]; gg[bb][i] = gp[vo + (bb * 16 + i) * LDP]; }
#pragma unroll
        for (int tb = 0; tb < 8; ++tb) {
            if (tb + 2 < 8) {
#pragma unroll
                for (int i = 0; i < 16; ++i) { pk[(tb + 2) % 3][i] = rp[vo + ((tb + 2) * 16 + i) * 1024]; gg[(tb + 2) % 3][i] = gp[vo + ((tb + 2) * 16 + i) * LDP]; }
            }
#pragma unroll
            for (int i = 0; i < 16; ++i) {
                h = __expf(bflo(pk[tb % 3][i])) * h + bfhi(pk[tb % 3][i]);
                gp[vo + (tb * 16 + i) * LDP] = f2bf(h * geluf_(bf2f(gg[tb % 3][i])));
            }
        }
        if ((T & 15) == 15) p.out[O_PRGH + (size_t)(T >> 4) * 1024 + ch] = h;
    }
    const int gt = bid * 512 + tid, nthr = G * 512;
    for (int i = gt; i < 8 * 3 * 1024; i += nthr) { const int c = i & 1023, k = (i >> 10) % 3, b = i / 3072; p.out[O_PRGC + i] = bf2f(proj[(size_t)(b * 2048 + 2045 + k) * LDP + c]); }
    for (int i = gt; i < 8 * 3 * 4096; i += nthr) { const int c = i & 4095, k = (i >> 12) % 3, b = i / 12288; p.out[O_PSSDC + i] = bf2f(proj[(size_t)(b * 2048 + 2045 + k) * LDP + 4096 + c]); }
    for (int i = gt; i < 128 * 3 * 1024; i += nthr) { const int c = i & 1023, k = (i >> 10) % 3, s = i / 3072; p.out[O_SRGC + i] = bf2f(proj[(size_t)(MP + s * 4 + 1 + k) * LDP + c]); }
    for (int i0 = gt; i0 < 128 * 3 * 4096; i0 += nthr * 4) {
        bf16_t v[4];
#pragma unroll
        for (int u = 0; u < 4; ++u) { const int i = i0 + u * nthr; if (i < 128 * 3 * 4096) { const int c = i & 4095, k = (i >> 12) % 3, s = i / 12288; v[u] = proj[(size_t)(MP + s * 4 + 1 + k) * LDP + 4096 + c]; } else v[u] = 0; }
#pragma unroll
        for (int u = 0; u < 4; ++u) { const int i = i0 + u * nthr; if (i < 128 * 3 * 4096) p.out[O_SSSDC + i] = bf2f(v[u]); }
    }
    {
        const int lane = tid & 63, wv = __builtin_amdgcn_readfirstlane(tid >> 6);
        const int rstep = G * 8;
        for (int rowa = bid * 8 + wv; rowa < MTOT; rowa += 2 * rstep) {
            u32x2 v[2][8]; float ss[2][8];
#pragma unroll
            for (int q = 0; q < 2; ++q) {
                const int row = rowa + q * rstep < MTOT ? rowa + q * rstep : rowa;
                const bf16_t* yp = proj + (size_t)row * LDP + 2048 + lane * 4;
#pragma unroll
                for (int gI = 0; gI < 8; ++gI) v[q][gI] = *(const u32x2*)(yp + gI * 256);
            }
#pragma unroll
            for (int q = 0; q < 2; ++q)
#pragma unroll
                for (int gI = 0; gI < 8; ++gI) { const float f0 = bflo(v[q][gI][0]), f1 = bfhi(v[q][gI][0]), f2 = bflo(v[q][gI][1]), f3 = bfhi(v[q][gI][1]); ss[q][gI] = f0 * f0 + f1 * f1 + f2 * f2 + f3 * f3; }
#pragma unroll
            for (int o = 32; o; o >>= 1)
#pragma unroll
                for (int q = 0; q < 2; ++q)
#pragma unroll
                    for (int gI = 0; gI < 8; ++gI) ss[q][gI] += bperm(ss[q][gI], lane ^ o);
#pragma unroll
            for (int q = 0; q < 2; ++q) {
                if (q == 1 && rowa + rstep >= MTOT) break;
                bf16_t* yp = proj + (size_t)(rowa + q * rstep) * LDP + 2048 + lane * 4;
#pragma unroll
                for (int gI = 0; gI < 8; ++gI) {
                    const float r = rsqrtf(ss[q][gI] * (1.f / 256.f) + 1e-6f);
                    const float4 w4 = *(const float4*)(p.in[26] + gI * 256 + lane * 4);
                    u32x2 o; o[0] = pk_bf16(bflo(v[q][gI][0]) * r * w4.x, bfhi(v[q][gI][0]) * r * w4.y); o[1] = pk_bf16(bflo(v[q][gI][1]) * r * w4.z, bfhi(v[q][gI][1]) * r * w4.w);
                    *(u32x2*)(yp + gI * 256) = o;
                }
            }
        }
    }
}

#define XB_TMO      128
#define XB_XCNT(j)  (256  + 64 * (j))
#define XB_XSUB(j)  (1280 + 64 * (j))
#define XB_XGEN(j)  (2304 + 64 * (j))
#define XB_TOP      3328
#define XB_TOPGEN   3392
#define XCD_BAR_WORDS 3456
#define XB_SPIN_CAP (1u << 18)
__device__ __forceinline__ unsigned xb_ld(unsigned* p)              { return __hip_atomic_load(p, __ATOMIC_RELAXED, __HIP_MEMORY_SCOPE_AGENT); }
__device__ __forceinline__ unsigned xb_add(unsigned* p, unsigned v) { return __hip_atomic_fetch_add(p, v, __ATOMIC_RELAXED, __HIP_MEMORY_SCOPE_AGENT); }
__device__ __forceinline__ unsigned xb_xcc_id() { return (unsigned)__builtin_amdgcn_s_getreg((3 << 11) | 20) & 0xFu; }
#define XB_SPIN(cond, bar) do { unsigned _sp = 0; while (cond) { __builtin_amdgcn_s_sleep(8);   \
    if ((++_sp & 255u) == 0u) { if (xb_ld(&(bar)[XB_TMO])) break; if (_sp > XB_SPIN_CAP) { atomicAdd(&(bar)[XB_TMO], 1u); break; } } } } while (0)
struct XcdBarrier { unsigned* bar; unsigned x; volatile LAS unsigned* st; };
__device__ __forceinline__ XcdBarrier xcd_barrier_post(unsigned* bar, volatile LAS unsigned* st) {
    XcdBarrier b; b.bar = bar; b.x = xb_xcc_id(); b.st = st;
    if (threadIdx.x == 0) (void)xb_add(&bar[XB_XCNT(b.x)], 1u);
    return b;
}
__device__ __forceinline__ void xcd_barrier_complete(unsigned* bar, unsigned x, unsigned& nloc, unsigned& nx) {
    const unsigned G = gridDim.x * gridDim.y * gridDim.z;
    unsigned sum, cnt, mine, sp = 0u;
    for (;;) {
        sum = 0u; cnt = 0u; mine = 0u;
#pragma unroll
        for (unsigned j = 0; j < 16; ++j) { const unsigned c = xb_ld(&bar[XB_XCNT(j)]); sum += c; cnt += (c > 0u) ? 1u : 0u; mine = (j == x) ? c : mine; }
        if (sum == G) break;
        __builtin_amdgcn_s_sleep(1);
        if ((++sp & 255u) == 0u) { if (xb_ld(&bar[XB_TMO])) break; if (sp > XB_SPIN_CAP) { atomicAdd(&bar[XB_TMO], 1u); break; } }
    }
    nloc = mine > 0u ? mine : 1u; nx = cnt > 0u ? cnt : 1u;
}
__device__ __forceinline__ void xcd_barrier(const XcdBarrier& b) {
    asm volatile("s_waitcnt vmcnt(0)" ::: "memory");
    __syncthreads();
    if (threadIdx.x == 0) {
        unsigned* bar = b.bar;
        __builtin_amdgcn_s_waitcnt(0);
        unsigned nloc = b.st[0], nx = b.st[1];
        if (nloc == 0u) { xcd_barrier_complete(bar, b.x, nloc, nx); b.st[0] = nloc; b.st[1] = nx; }
        const unsigned old = xb_add(&bar[XB_XSUB(b.x)], 1u);
        const unsigned gen = old / nloc;
        if (old + 1u == (gen + 1u) * nloc) {
            __builtin_amdgcn_fence(__ATOMIC_RELEASE, "agent");
            asm volatile("s_waitcnt vmcnt(0)" ::: "memory");
            const unsigned og = xb_add(&bar[XB_TOP], 1u);
            const unsigned tg = og / nx;
            if (og + 1u == (tg + 1u) * nx) xb_add(&bar[XB_TOPGEN], 1u);
            else XB_SPIN(xb_ld(&bar[XB_TOPGEN]) == tg, bar);
            __builtin_amdgcn_fence(__ATOMIC_ACQUIRE, "agent");
            xb_add(&bar[XB_XGEN(b.x)], 1u);
            asm volatile("s_waitcnt vmcnt(0)" ::: "memory");
        } else {
            XB_SPIN(xb_ld(&bar[XB_XGEN(b.x)]) == gen, bar);
            __builtin_amdgcn_fence(__ATOMIC_ACQUIRE, "agent");
            asm volatile("s_waitcnt vmcnt(0)" ::: "memory");
        }
    }
    __syncthreads();
}

__global__ __launch_bounds__(512) void mega(Params p) {
    extern __shared__ __attribute__((aligned(16))) unsigned char shm[];
    LAS unsigned char* lds = (LAS unsigned char*)shm;
    cg::grid_group grid = cg::this_grid();
    unsigned char* ws = p.ws;
    bf16_t* xn = (bf16_t*)(ws + WS_XN);
    bf16_t* proj = (bf16_t*)(ws + WS_PROJ);
    bf16_t* act = proj;
    float* dbuf = (float*)(ws + WS_D);
    pg8::StaticOrder S;
    volatile LAS unsigned* xst = (volatile LAS unsigned*)(lds + 148992);
    if (threadIdx.x == 0) { xst[0] = 0u; xst[1] = 0u; }
    __syncthreads();
    const XcdBarrier xb = xcd_barrier_post((unsigned*)(ws + WS_BAR), xst);
#ifndef PROBE_REP
#define PROBE_REP 0
#endif
    int nbar = 0;
    for (int it = p.ph_lo; it < p.ph_hi; ++it) {
        int ph = it;
        if (PROBE_REP > 0) ph = it <= PROBE_REP ? it : it - 1;
        if (gdim_l() == 256 && (ph == 3 || ph == 10 || ph == 13)) continue;
        if (it > p.ph_lo) {
            if (nbar == 0) grid.sync();
            else xcd_barrier(xb);
            ++nbar;
        }
        __syncthreads();
        if (ph == 0) {
            phase_prep(p, lds);
        } else if (ph == 1 || ph == 11) {
            pg8::Gemm g{ph == 1 ? xn : (const bf16_t*)(ws + WS_XN2), (const bf16_t*)(ws + (ph == 1 ? WS_UP1 : WS_UP2)), MTOT, NUP, DM, DM};
            S.init(MTOT, NUP, gdim_l(), bid_l());
            EpiUp E{act};
            pg8::gemm_phase(lds, g, S, E);
            if (ph == 1 && gdim_l() == 256 && bid_l() >= 172) { __syncthreads(); prep_dn1(p, lds, 84, bid_l() - 172); }
        } else if (ph == 2 || ph == 12 || ph == 9) {
            pg8::Gemm g;
            if (ph == 9) g = pg8::Gemm{xn, (const bf16_t*)(ws + WS_OUT), MP, DM, DM, DM};
            else g = pg8::Gemm{act, (const bf16_t*)(ws + (ph == 2 ? WS_DN1 : WS_DN2)), MP, DM, DFF, DFF};
            S.init(MP, DM, gdim_l(), bid_l());
            if (gdim_l() == 256) {
                EpiNorm E;
                E.res = ph == 2 ? p.in[0] : p.out + O_Y; E.y = p.out + O_Y;
                E.xn = ph == 2 ? xn : (bf16_t*)(ws + WS_XN2);
                E.wpost = ph == 2 ? p.in[7] : (ph == 9 ? p.in[12] : p.in[31]);
                E.wnext = ph == 2 ? p.in[11] : (ph == 9 ? p.in[30] : nullptr);
                E.scale = ph == 9 ? 1.0f : 0.5f;
                E.slots = (unsigned long long*)(ws + WS_SLOTS); E.tag = (unsigned)ph;
                pg8::gemm_phase(lds, g, S, E);
                __syncthreads();
                SEpiNorm Es;
                Es.res = ph == 2 ? p.in[1] - (size_t)MP * DM : p.out + O_Y; Es.y = E.y; Es.xn = E.xn; Es.wpost = E.wpost; Es.wnext = E.wnext; Es.scale = E.scale;
                Es.slots = (unsigned long long*)(ws + WS_SSLOTS); Es.tag = (unsigned)ph;
                sgemm_s(lds, g.A, g.lda, g.Bt, g.K, Es);
            } else {
                EpiF32 E{(bf16_t*)dbuf};
                pg8::gemm_phase(lds, g, S, E);
                __syncthreads();
                SEpiF32 Es{(bf16_t*)dbuf};
                sgemm_s(lds, g.A, g.lda, g.Bt, g.K, Es);
            }
        } else if (ph == 3) {
            norm_pass(p, true, p.in[7], 0.5f, p.in[11], gdim_l() == 256 ? MP : 0, xn);
        } else if (ph == 10) {
            norm_pass(p, false, p.in[12], 1.0f, p.in[30], gdim_l() == 256 ? MP : 0, (bf16_t*)(ws + WS_XN2));
        } else if (ph == 13) {
            norm_pass(p, false, p.in[31], 0.5f, nullptr, gdim_l() == 256 ? MP : 0, xn);
        } else if (ph == 4) {
            pg8::Gemm g{xn, (const bf16_t*)(ws + WS_IN), MTOT, NIN, DM, DM};
            S.init(MTOT, NIN, gdim_l(), bid_l());
            EpiIn E{proj, (float*)(ws + WS_DT), p.in[23]};
            pg8::gemm_phase(lds, g, S, E);
            if (gdim_l() == 256 && bid_l() >= 146) { __syncthreads(); prep_late(p, lds, 110, bid_l() - 146); }
        } else if (ph == 5) {
            phase_bc(p);
            const int G = gdim_l(), bid = bid_l();
            RgPre rpre;
            { const int f0 = bid < 1056 ? bid : 0; rg_prefetch(p, f0 >> 3, f0 & 7, rpre); }
            for (int it2 = bid; it2 < 1056; it2 += G) {
                const int nx = it2 + G < 1056 ? it2 + G : it2;
                lds_barrier();
                rg_item(p, lds, it2 >> 3, it2 & 7, rpre, nx >> 3, nx & 7);
            }
        } else if (ph == 6) {
            phase_m1(p, lds);
        } else if (ph == 7) {
            phase_m3(p);
        } else if (ph == 8) {
            S.init(MP, DM, gdim_l(), bid_l());
            {
                pg8::Gemm g{proj + 1024, (const bf16_t*)(ws + WS_PRG), MP, DM, 3072, LDP};
                EpiGateCat E{proj + 8192, proj + 9216, xn};
                pg8::gemm_phase(lds, g, S, E);
            }
            __syncthreads();
            { SEpiGate1 Es{proj + 8192, (bf16_t*)dbuf}; sgemm_s(lds, proj + 1024, LDP, (const bf16_t*)(ws + WS_PRG), DM, Es, 3072); }
            { SEpiGate2 Es{proj + 9216, (const bf16_t*)dbuf, xn}; sgemm_s(lds, proj + 2048, LDP, (const bf16_t*)(ws + WS_PRG) + 1024, 2048, Es, 3072); }
        }
    }
}

extern "C" void kernel_launch(void* const* d_in, const int* in_sizes, int n_in, void* d_out, int out_size, void* d_ws, size_t ws_size, hipStream_t stream) {
    static int grid_blocks = 0;
    if (!grid_blocks) {
        if (n_in != 35 || ws_size < WS_NEED) { fprintf(stderr, "kernel_launch: unexpected n_in %d / ws_size %zu (need %zu)\n", n_in, ws_size, (size_t)WS_NEED); grid_blocks = -1; return; }
        int dev = 0, cus = 0, per_cu = 0;
        hipGetDevice(&dev);
        hipDeviceGetAttribute(&cus, hipDeviceAttributeMultiprocessorCount, dev);
        if (hipFuncSetAttribute((const void*)mega, hipFuncAttributeMaxDynamicSharedMemorySize, LDS_BYTES) != hipSuccess) { fprintf(stderr, "kernel_launch: hipFuncSetAttribute failed\n"); grid_blocks = -1; return; }
        if (hipOccupancyMaxActiveBlocksPerMultiprocessor(&per_cu, (const void*)mega, 512, LDS_BYTES) != hipSuccess || per_cu < 1) { fprintf(stderr, "kernel_launch: occupancy query failed (%d)\n", per_cu); grid_blocks = -1; return; }
        grid_blocks = cus * per_cu;
    }
    if (grid_blocks < 0) return;
    Params p{};
    for (int i = 0; i < 35; ++i) p.in[i] = (const float*)d_in[i];
    p.out = (float*)d_out; p.ws = (unsigned char*)d_ws;
#if MULTI_LAUNCH
    for (int ph = 0; ph < NPH; ++ph) {
        p.ph_lo = ph; p.ph_hi = ph + 1;
        hipLaunchKernelGGL(mega, dim3(grid_blocks), dim3(512), LDS_BYTES, stream, p);
    }
#else
    p.ph_lo = 0; p.ph_hi = NPH + (PROBE_REP > 0 ? 1 : 0);
    if (hipMemsetAsync((char*)d_ws + WS_BAR, 0, 16384, stream) != hipSuccess) { fprintf(stderr, "kernel_launch: memset of the barrier word failed\n"); return; }
    void* args[] = {&p};
    hipError_t e = hipLaunchCooperativeKernel((const void*)mega, dim3(grid_blocks), dim3(512), args, LDS_BYTES, stream);
    if (e != hipSuccess) fprintf(stderr, "cooperative launch failed: %s (grid %d)\n", hipGetErrorString(e), grid_blocks);
#endif
}
```
